# Optimizing an MI355X kernel written in HIP

```python
import jax, jax.numpy as jnp
from jax import lax
import numpy as np

D_MODEL = 2048
BATCH = 8
SEQ = 4096
DEPTH = 1
DEC_BATCH = 32
DEC_SEQ = 16
PAST_LEN = 4096

CHUNK = 64
N_META = 16
RMS_EPS = 1e-6
D_FF = 5504
RW_WIDTH = D_MODEL // 2
RW_HEAD = 64
RW_HEADS = RW_WIDTH // RW_HEAD
RW_DECAY_LORA = 64
RW_A_LORA = 64
RW_GATE_LORA = 160
RW_COLS = 3 * RW_WIDTH + RW_DECAY_LORA + RW_A_LORA + RW_GATE_LORA
RW_GN_EPS = 64e-5
ML_WIDTH = D_MODEL // 2
ML_HEADS = 4
ML_HEAD = ML_WIDTH // ML_HEADS
ML_CONV = 4
ML_LN_EPS = 1e-5
ML_COLS = 4 * ML_WIDTH + 2 * ML_HEADS
GATE_COLS = 2 * D_MODEL
IN_COLS = RW_COLS + ML_COLS + GATE_COLS

kernel_name = "rwkv7_mlstm_gated_hybrid_stream_step"


def _rmsnorm(x, g):
    xf = x.astype(jnp.float32)
    y = xf * lax.rsqrt(jnp.mean(xf * xf, -1, keepdims=True) + RMS_EPS)
    return (y * g.astype(jnp.float32)).astype(x.dtype)


def _swiglu(x, w_gate, w_up, w_down):
    return (jax.nn.silu(x @ w_gate) * (x @ w_up)) @ w_down


def _norm_last(y, eps):
    mu = jnp.mean(y, -1, keepdims=True)
    var = jnp.mean(jnp.square(y - mu), -1, keepdims=True)
    return (y - mu) * lax.rsqrt(var + eps)


def _causal_conv(u, buf, w, b):
    T = u.shape[1]
    padded = jnp.concatenate([buf.astype(u.dtype), u], 1)
    out = b.astype(u.dtype)
    for j in range(ML_CONV):
        out = out + w[j].astype(u.dtype) * padded[:, j:j + T]
    return out, padded[:, T:]


def _rwkv7_scan(r, w, k, v, a_vec, b_vec, S0):
    def step(S, inp):
        r_t, w_t, k_t, v_t, a_t, b_t = inp
        sa = jnp.einsum('bhvk,bhk->bhv', S, a_t)
        S = S * w_t[:, :, None, :] + sa[..., None] * b_t[:, :, None, :] + v_t[..., None] * k_t[:, :, None, :]
        return S, jnp.einsum('bhvk,bhk->bhv', S, r_t)
    xs = tuple(jnp.moveaxis(t, 1, 0) for t in (r, w, k, v, a_vec, b_vec))
    S, ys = lax.scan(step, S0, xs)
    return jnp.moveaxis(ys, 0, 1), S


def _mlstm_chunkwise(q, k, v, i_pre, logf, C0, n0, m0, L):
    B, H, T, d = q.shape
    nc = T // L

    def to_chunks(t):
        t = t.reshape(B, H, nc, L, *t.shape[3:])
        return jnp.moveaxis(t, 2, 0)

    causal = jnp.tril(jnp.ones((L, L), bool))

    def step(carry, inp):
        C, n, m = carry
        qc, kc, vc, ic, fc = inp
        b = jnp.cumsum(fc, -1)
        log_inter = b + m[..., None]
        D = b[..., :, None] - b[..., None, :] + ic[..., None, :]
        D = jnp.where(causal, D, -jnp.inf)
        m_q = jnp.maximum(log_inter, jnp.max(D, -1))
        w_inter = jnp.exp(log_inter - m_q)
        s = jnp.einsum('bhtd,bhsd->bhts', qc, kc) * jnp.exp(D - m_q[..., None])
        num = w_inter[..., None] * jnp.einsum('bhtk,bhkv->bhtv', qc, C) + jnp.einsum('bhts,bhsv->bhtv', s, vc)
        den = w_inter * jnp.einsum('bhtk,bhk->bht', qc, n) + jnp.sum(s, -1)
        h = num / jnp.maximum(jnp.abs(den), jnp.exp(-m_q))[..., None]
        g = b[..., -1:] - b + ic
        m_new = jnp.maximum(b[..., -1] + m, jnp.max(g, -1))
        a_st = jnp.exp(b[..., -1] + m - m_new)
        wk = jnp.exp(g - m_new[..., None])
        C = a_st[..., None, None] * C + jnp.einsum('bhs,bhsk,bhsv->bhkv', wk, kc, vc)
        n = a_st[..., None] * n + jnp.einsum('bhs,bhsk->bhk', wk, kc)
        return (C, n, m_new), h

    (C, n, m), hs = lax.scan(step, (C0, n0, m0), tuple(map(to_chunks, (q, k, v, i_pre, logf))))
    h = jnp.moveaxis(hs, 0, 2).reshape(B, H, T, d)
    return h, C, n, m


def _mixer(h, states, prm, l, n_lead):
    f32 = jnp.float32
    rw_shift0, rw_S0, ml_conv0, ml_C0, ml_n0, ml_m0 = states
    B, T, _ = h.shape
    proj = (h @ prm['w_in'][l]).astype(f32)
    o1 = RW_COLS
    o2 = o1 + 2 * ML_WIDTH
    o3 = o2 + ML_WIDTH
    o4 = o3 + ML_WIDTH
    o5 = o4 + ML_HEADS
    o6 = o5 + ML_HEADS
    p_rw, p_qk, p_v, p_o = proj[..., :o1], proj[..., o1:o2], proj[..., o2:o3], proj[..., o3:o4]
    p_i, p_f, p_gate = proj[..., o4:o5], proj[..., o5:o6], proj[..., o6:]

    prev = jnp.concatenate([rw_shift0[:, None].astype(f32), p_rw[:, :-1]], 1)
    u = p_rw + prm['rw_mu'][l].astype(f32) * (prev - p_rw)
    new_rw_shift = p_rw[:, -1]
    W = RW_WIDTH
    r, k, v = u[..., :W], u[..., W:2 * W], u[..., 2 * W:3 * W]
    lw = u[..., 3 * W:3 * W + RW_DECAY_LORA]
    la = u[..., 3 * W + RW_DECAY_LORA:3 * W + RW_DECAY_LORA + RW_A_LORA]
    lg = u[..., 3 * W + RW_DECAY_LORA + RW_A_LORA:]
    wlog = -jax.nn.softplus(-(prm['rw_w0'][l] + jnp.tanh(lw) @ prm['rw_w2'][l])) - 0.5
    decay = jnp.exp(-jnp.exp(wlog.astype(f32)))
    a = jax.nn.sigmoid((prm['rw_a0'][l] + la @ prm['rw_a2'][l]).astype(f32))
    g = (jax.nn.sigmoid(lg) @ prm['rw_g2'][l]).astype(f32)
    heads = lambda t: t.reshape(B, T, RW_HEADS, RW_HEAD)
    kk = heads(k * prm['rw_kk'][l])
    kk = (kk / jnp.maximum(jnp.sqrt(jnp.sum(kk * kk, -1, keepdims=True)), 1e-12)).astype(f32)
    k = (k * (1.0 + (a - 1.0) * prm['rw_ka'][l])).astype(f32)
    rh, kh, vh, ah, wh = heads(r), heads(k), heads(v), heads(a), heads(decay)
    y, new_rw_S = _rwkv7_scan(rh, wh, kh, vh, -kk, kk * ah, rw_S0.astype(f32))
    y = _norm_last(y, RW_GN_EPS).reshape(B, T, W) * prm['rw_ln_w'][l] + prm['rw_ln_b'][l]
    bonus = jnp.sum(rh * kh * prm['rw_rk'][l].astype(f32), -1, keepdims=True) * vh
    y_rw = ((y + bonus.reshape(B, T, W)) * g).astype(f32)

    qk, new_ml_conv = _causal_conv(p_qk, ml_conv0, prm['ml_conv_w'][l], prm['ml_conv_b'][l])
    qk = jax.nn.silu(qk.astype(f32))
    mh = lambda t: t.reshape(B, T, ML_HEADS, ML_HEAD).transpose(0, 2, 1, 3)
    q = mh(qk[..., :ML_WIDTH])
    km = mh(qk[..., ML_WIDTH:] * (ML_HEAD ** -0.5))
    vm = mh(p_v)
    i_pre = (p_i + prm['ml_i_b'][l]).astype(f32).transpose(0, 2, 1)
    logf = jax.nn.log_sigmoid((p_f + prm['ml_f_b'][l]).astype(f32)).transpose(0, 2, 1)
    C, n, m = ml_C0.astype(f32), ml_n0.astype(f32), ml_m0.astype(f32)
    segments = [(0, n_lead, n_lead), (n_lead, T, min(CHUNK, T - n_lead))] if n_lead > 0 else [(0, T, min(CHUNK, T))]
    hs = []
    for (s0, s1, L) in segments:
        hseg, C, n, m = _mlstm_chunkwise(q[:, :, s0:s1], km[:, :, s0:s1], vm[:, :, s0:s1],
                                         i_pre[..., s0:s1], logf[..., s0:s1], C, n, m, L)
        hs.append(hseg)
    hm = jnp.concatenate(hs, 2)
    hm = _norm_last(hm, ML_LN_EPS).transpose(0, 2, 1, 3).reshape(B, T, ML_WIDTH)
    y_ml = hm * prm['ml_norm_w'][l] * jax.nn.sigmoid(p_o)

    gates = jax.nn.sigmoid(p_gate)
    merged = gates[..., :D_MODEL] * (y_rw @ prm['w_br_rw'][l]) + gates[..., D_MODEL:] * (y_ml @ prm['w_br_ml'][l])
    out = (merged @ prm['w_out'][l]).astype(h.dtype)
    return out, (new_rw_shift, new_rw_S, new_ml_conv, C, n, m)


def _trunk(x, states, prm, n_lead):
    collected = []
    for l in range(DEPTH):
        x = x + 0.5 * _swiglu(_rmsnorm(x, prm['ffn1_norm'][l]), prm['ffn1_w_gate'][l], prm['ffn1_w_up'][l], prm['ffn1_w_down'][l])
        mix, ns = _mixer(_rmsnorm(x, prm['mix_norm'][l]), tuple(s[l] for s in states), prm, l, n_lead)
        x = x + mix
        x = x + 0.5 * _swiglu(_rmsnorm(x, prm['ffn2_norm'][l]), prm['ffn2_w_gate'][l], prm['ffn2_w_up'][l], prm['ffn2_w_down'][l])
        collected.append(ns)
    new_states = tuple(jnp.stack([ns[i] for ns in collected]) for i in range(len(collected[0])))
    return _rmsnorm(x, prm['final_norm']), new_states


def setup_inputs(seed: int = 0) -> dict:
    key = jax.random.key(seed)
    ks = iter(jax.random.split(key, 48))
    nrm = lambda shape, s: jax.random.normal(next(ks), shape, jnp.float32) * s
    uni = lambda shape, lo, hi: jax.random.uniform(next(ks), shape, jnp.float32, lo, hi)
    Dp = DEPTH
    f_bias = jnp.broadcast_to(jnp.linspace(3.0, 6.0, ML_HEADS, dtype=jnp.float32), (Dp, ML_HEADS))
    return {
        "x_prompt": nrm((BATCH, SEQ, D_MODEL), 1.0),
        "x_sample": nrm((DEC_BATCH, DEC_SEQ, D_MODEL), 1.0),
        "state_rwkv_shift": nrm((Dp, DEC_BATCH, RW_COLS), 1.0),
        "state_rwkv_wkv": nrm((Dp, DEC_BATCH, RW_HEADS, RW_HEAD, RW_HEAD), 0.1),
        "state_mlstm_conv": nrm((Dp, DEC_BATCH, ML_CONV - 1, 2 * ML_WIDTH), 1.0),
        "state_mlstm_C": nrm((Dp, DEC_BATCH, ML_HEADS, ML_HEAD, ML_HEAD), 0.05),
        "state_mlstm_n": nrm((Dp, DEC_BATCH, ML_HEADS, ML_HEAD), 0.5),
        "state_mlstm_m": nrm((Dp, DEC_BATCH, ML_HEADS), 1.0),
        "meta_tokens": nrm((N_META, D_MODEL), 1.0),
        "ffn1_norm": 1.0 + nrm((Dp, D_MODEL), 0.02),
        "ffn1_w_gate": nrm((Dp, D_MODEL, D_FF), D_MODEL ** -0.5),
        "ffn1_w_up": nrm((Dp, D_MODEL, D_FF), D_MODEL ** -0.5),
        "ffn1_w_down": nrm((Dp, D_FF, D_MODEL), D_FF ** -0.5),
        "mix_norm": 1.0 + nrm((Dp, D_MODEL), 0.02),
        "w_in": nrm((Dp, D_MODEL, IN_COLS), D_MODEL ** -0.5),
        "rw_mu": uni((Dp, RW_COLS), 0.0, 1.0),
        "rw_w0": uni((Dp, RW_WIDTH), -6.0, 0.0),
        "rw_w2": nrm((Dp, RW_DECAY_LORA, RW_WIDTH), 0.1),
        "rw_a0": nrm((Dp, RW_WIDTH), 0.5),
        "rw_a2": nrm((Dp, RW_A_LORA, RW_WIDTH), 0.5 * RW_A_LORA ** -0.5),
        "rw_g2": nrm((Dp, RW_GATE_LORA, RW_WIDTH), RW_GATE_LORA ** -0.5),
        "rw_kk": 1.0 + nrm((Dp, RW_WIDTH), 0.1),
        "rw_ka": 1.0 + nrm((Dp, RW_WIDTH), 0.1),
        "rw_rk": nrm((Dp, RW_HEADS, RW_HEAD), 0.1),
        "rw_ln_w": 1.0 + nrm((Dp, RW_WIDTH), 0.02),
        "rw_ln_b": nrm((Dp, RW_WIDTH), 0.02),
        "ml_conv_w": nrm((Dp, ML_CONV, 2 * ML_WIDTH), 0.5),
        "ml_conv_b": nrm((Dp, 2 * ML_WIDTH), 0.02),
        "ml_i_b": nrm((Dp, ML_HEADS), 0.1),
        "ml_f_b": f_bias + nrm((Dp, ML_HEADS), 0.1),
        "ml_norm_w": 1.0 + nrm((Dp, ML_WIDTH), 0.02),
        "w_br_rw": nrm((Dp, RW_WIDTH, D_MODEL), RW_WIDTH ** -0.5),
        "w_br_ml": nrm((Dp, ML_WIDTH, D_MODEL), ML_WIDTH ** -0.5),
        "w_out": nrm((Dp, D_MODEL, D_MODEL), D_MODEL ** -0.5),
        "ffn2_norm": 1.0 + nrm((Dp, D_MODEL), 0.02),
        "ffn2_w_gate": nrm((Dp, D_MODEL, D_FF), D_MODEL ** -0.5),
        "ffn2_w_up": nrm((Dp, D_MODEL, D_FF), D_MODEL ** -0.5),
        "ffn2_w_down": nrm((Dp, D_FF, D_MODEL), D_FF ** -0.5),
        "final_norm": 1.0 + nrm((D_MODEL,), 0.02),
    }


def reference(x_prompt, x_sample, state_rwkv_shift, state_rwkv_wkv, state_mlstm_conv, state_mlstm_C,
              state_mlstm_n, state_mlstm_m, meta_tokens, ffn1_norm, ffn1_w_gate, ffn1_w_up, ffn1_w_down,
              mix_norm, w_in, rw_mu, rw_w0, rw_w2, rw_a0, rw_a2, rw_g2, rw_kk, rw_ka, rw_rk, rw_ln_w, rw_ln_b,
              ml_conv_w, ml_conv_b, ml_i_b, ml_f_b, ml_norm_w, w_br_rw, w_br_ml, w_out,
              ffn2_norm, ffn2_w_gate, ffn2_w_up, ffn2_w_down, final_norm):
    f32 = jnp.float32
    prm = dict(ffn1_norm=ffn1_norm, ffn1_w_gate=ffn1_w_gate, ffn1_w_up=ffn1_w_up, ffn1_w_down=ffn1_w_down,
               mix_norm=mix_norm, w_in=w_in, rw_mu=rw_mu, rw_w0=rw_w0, rw_w2=rw_w2, rw_a0=rw_a0, rw_a2=rw_a2,
               rw_g2=rw_g2, rw_kk=rw_kk, rw_ka=rw_ka, rw_rk=rw_rk, rw_ln_w=rw_ln_w, rw_ln_b=rw_ln_b,
               ml_conv_w=ml_conv_w, ml_conv_b=ml_conv_b, ml_i_b=ml_i_b, ml_f_b=ml_f_b, ml_norm_w=ml_norm_w,
               w_br_rw=w_br_rw, w_br_ml=w_br_ml, w_out=w_out, ffn2_norm=ffn2_norm, ffn2_w_gate=ffn2_w_gate,
               ffn2_w_up=ffn2_w_up, ffn2_w_down=ffn2_w_down, final_norm=final_norm)

    B = x_prompt.shape[0]
    meta = jnp.broadcast_to(meta_tokens.astype(x_prompt.dtype)[None], (B, N_META, D_MODEL))
    xp = jnp.concatenate([meta, x_prompt], 1)
    zero_states = (jnp.zeros((DEPTH, B, RW_COLS), f32),
                   jnp.zeros((DEPTH, B, RW_HEADS, RW_HEAD, RW_HEAD), f32),
                   jnp.zeros((DEPTH, B, ML_CONV - 1, 2 * ML_WIDTH), f32),
                   jnp.zeros((DEPTH, B, ML_HEADS, ML_HEAD, ML_HEAD), f32),
                   jnp.zeros((DEPTH, B, ML_HEADS, ML_HEAD), f32),
                   jnp.zeros((DEPTH, B, ML_HEADS), f32))
    yp, (p_rw_shift, p_rw_wkv, p_ml_conv, p_ml_C, p_ml_n, p_ml_m) = _trunk(xp, zero_states, prm, N_META)
    y_prompt = yp[:, N_META:]

    s_states = (state_rwkv_shift, state_rwkv_wkv, state_mlstm_conv, state_mlstm_C, state_mlstm_n, state_mlstm_m)
    y_sample, (s_rw_shift, s_rw_wkv, s_ml_conv, s_ml_C, s_ml_n, s_ml_m) = _trunk(x_sample, s_states, prm, 0)

    return (y_prompt, y_sample,
            p_rw_shift, p_rw_wkv, p_ml_conv, p_ml_C, p_ml_n, p_ml_m,
            s_rw_shift, s_rw_wkv, s_ml_conv, s_ml_C, s_ml_n, s_ml_m)
```

```cpp
#include <hip/hip_runtime.h>
#include <hip/hip_cooperative_groups.h>
#include <cstdio>
#include <cstdint>
namespace cg = cooperative_groups;
#define DI __device__ __forceinline__
#define LAS __attribute__((address_space(3)))
namespace pg8 {
#define PG8_LAS __attribute__((address_space(3)))
typedef unsigned short bf16_t;
typedef short bf16x8 __attribute__((ext_vector_type(8)));
typedef float f32x4 __attribute__((ext_vector_type(4)));
typedef unsigned u32x4 __attribute__((ext_vector_type(4)));
constexpr int BM = 256, BK = 64, HALF = 128, HTB = HALF * BK * 2  , STAGE_BYTES = 8 * HTB, NXCD = 8, WGM = 8;

__host__ __device__ __forceinline__ int lds_byte(int r, int c) { const int st = (r >> 4) * 2 + (c >> 5), rr = r & 15, cc = c & 31, ob = rr * 64 + cc * 2; return st * 1024 + (ob ^ (((ob >> 9) & 1) << 5)); }
__host__ __device__ __forceinline__ void stage_rc(int b, int& R, int& C) { const int st = b / 1024, sb = b % 1024, swz = sb ^ (((sb >> 9) & 1) << 5); R = (st >> 1) * 16 + swz / 64; C = (st & 1) * 32 + (swz % 64) / 2; }
__host__ __device__ __forceinline__ int perm32(int rho) { const int n = rho >> 4, i = rho & 15; return 8 * (i >> 2) + 4 * n + (i & 3); }

struct Unit { int pm, pn; };
struct Gemm { const bf16_t* A; const bf16_t* Bt; int M, N, K; };

struct StaticOrder {
    int nM, nN, nwg, G, c;
    __host__ __device__ void init(int M, int N, int G_, int c_) { nM = M / BM; nN = N / BM; nwg = nM * nN; G = G_; c = c_; }
    __host__ __device__ bool next(int i, Unit& u) const {
        const long L = (long)i * G + c; if (L >= nwg) return false;
        int wgid = (int)L; { const int q = nwg / NXCD, r = nwg % NXCD, xcd = wgid % NXCD, off = wgid / NXCD; wgid = (xcd < r ? xcd * (q + 1) : r * (q + 1) + (xcd - r) * q) + off; }
        const int nig = WGM * nN, gid = wgid / nig, fm = gid * WGM, gsz = (nM - fm) < WGM ? (nM - fm) : WGM;
        u.pm = fm + ((wgid % nig) % gsz); u.pn = (wgid % nig) / gsz; return true;
    }
    __device__ __forceinline__ void a_ready(const Unit&) const {}
    __device__ __forceinline__ void done(const Unit&) const {}
};
__device__ __forceinline__ unsigned cvt_pk_bf16(float lo, float hi) { unsigned r; asm volatile("v_cvt_pk_bf16_f32 %0, %1, %2" : "=v"(r) : "v"(lo), "v"(hi)); return r; }
template <class Epi, class Sched, bool STAMP = false>
__device__ __forceinline__ void gemm_phase(PG8_LAS unsigned char* lds, const Gemm g, const Sched& S, const Epi& E, unsigned long long* stamps) {
    int tid_ = threadIdx.x; asm volatile("" : "+v"(tid_));
    const int tid = tid_, wid = __builtin_amdgcn_readfirstlane(tid >> 6), lane = tid & 63, wr = wid >> 2, wc = wid & 3, fr = lane & 15, fq = lane >> 4;
    const int K = g.K, nt = K / BK;
    int ts_lo = 0, ts_hi = 0, nts = 0; const unsigned long long rt_entry = STAMP ? (unsigned long long)wall_clock64() : 0ull;
#define PG8_STAMP() do { if (STAMP && wid == 0 && nts < 64) { const unsigned long long _c = (unsigned long long)clock64(); \
        ts_lo = (lane == nts) ? (int)(unsigned)_c : ts_lo; ts_hi = (lane == nts) ? (int)(unsigned)(_c >> 32) : ts_hi; ++nts; } } while (0)
    PG8_STAMP();
    unsigned voffA[2], voffB[2];
#pragma unroll
    for (int i = 0; i < 2; ++i) { int R, C; stage_rc(tid * 16 + i * 8192, R, C); const int Rb = Epi::PERM ? ((R & ~31) + perm32(R & 31)) : R;
        voffA[i] = (unsigned)(R * K + C) * 2u; voffB[i] = (unsigned)(Rb * K + C) * 2u; }
    const size_t kstep = (size_t)(BK * 2);
    const size_t hstep = (size_t)HALF * K * 2;
    const size_t tstep = 2 * hstep;
    const unsigned ldsw = (unsigned)wid * 1024u;
    const int aoff = lds_byte(wr * 64 + fr, fq * 8), boff = lds_byte(wc * 32 + fr, fq * 8);
#define PG8_SA(b, h) (((b) * 2 + (h)) * HTB)
#define PG8_SB(b, h) ((4 + (b) * 2 + (h)) * HTB)
#define PG8_STAGE(bufoff, gbase, voff) do { _Pragma("unroll") for (int _i = 0; _i < 2; ++_i) \
        __builtin_amdgcn_global_load_lds((const unsigned*)((const char*)(gbase) + (voff)[_i]), (PG8_LAS unsigned*)(lds + (bufoff) + ldsw + _i * 8192), 16, 0, 0); } while (0)
#define PG8_LDA(dst, b, h) do { _Pragma("unroll") for (int m = 0; m < 4; ++m) _Pragma("unroll") for (int k = 0; k < 2; ++k) dst[m][k] = *(const PG8_LAS bf16x8*)(lds + PG8_SA(b, h) + aoff + m * 2048 + k * 1024); } while (0)
#define PG8_LDB(dst, b, h) do { _Pragma("unroll") for (int n = 0; n < 2; ++n) _Pragma("unroll") for (int k = 0; k < 2; ++k) dst[n][k] = *(const PG8_LAS bf16x8*)(lds + PG8_SB(b, h) + boff + n * 2048 + k * 1024); } while (0)
#define PG8_MMA(ai, bj, At, Bt) do { __builtin_amdgcn_s_setprio(1); _Pragma("unroll") for (int m = 0; m < 4; ++m) _Pragma("unroll") for (int n = 0; n < 2; ++n) _Pragma("unroll") for (int k = 0; k < 2; ++k) \
        acc[ai][bj][m][n] = __builtin_amdgcn_mfma_f32_16x16x32_bf16(Bt[n][k], At[m][k], acc[ai][bj][m][n], 0, 0, 0); __builtin_amdgcn_s_setprio(0); } while (0)
#define PG8_WAIT_V(n) asm volatile("s_waitcnt vmcnt(" #n ")" ::: "memory")
#define PG8_WAIT_L(n) asm volatile("s_waitcnt lgkmcnt(" #n ")" ::: "memory")
#define PG8_BAR __builtin_amdgcn_s_barrier()
#define PG8_SCHED __builtin_amdgcn_sched_barrier(0)
    Unit cur, nxt; int ui = 0;
    if (!S.next(0, cur)) return;
    f32x4 acc[2][2][4][2];
#pragma unroll
    for (int a = 0; a < 2; ++a)
#pragma unroll
        for (int b = 0; b < 2; ++b)
#pragma unroll
            for (int m = 0; m < 4; ++m)
#pragma unroll
                for (int n = 0; n < 2; ++n) acc[a][b][m][n] = (f32x4){0.f, 0.f, 0.f, 0.f};
    bf16x8 At[4][2], B0[2][2], B1[2][2];
    const char* cA = (const char*)g.A + (size_t)cur.pm * tstep; const char* cB = (const char*)g.Bt + (size_t)cur.pn * tstep;
    S.a_ready(cur);
    PG8_STAGE(PG8_SB(0, 0), cB, voffB); PG8_STAGE(PG8_SA(0, 0), cA, voffA); PG8_STAGE(PG8_SB(0, 1), cB + hstep, voffB); PG8_STAGE(PG8_SA(0, 1), cA + hstep, voffA);
    if (wr == 1) PG8_BAR;
    PG8_WAIT_V(4); PG8_BAR;
    PG8_STAGE(PG8_SB(1, 0), cB + kstep, voffB); PG8_STAGE(PG8_SA(1, 0), cA + kstep, voffA); PG8_STAGE(PG8_SB(1, 1), cB + hstep + kstep, voffB);
    PG8_WAIT_V(6); PG8_BAR;
    PG8_STAMP();
    for (;;) {
        const bool has_next = S.next(ui + 1, nxt);
        const char* nA = has_next ? (const char*)g.A + (size_t)nxt.pm * tstep : cA; const char* nB = has_next ? (const char*)g.Bt + (size_t)nxt.pn * tstep : cB;
        for (int t = 0; t < nt; t += 2) {
            const bool last = (t == nt - 2);
            const char* a1 = cA + (size_t)(t + 1) * kstep;
            const char* a2 = last ? nA : cA + (size_t)(t + 2) * kstep; const char* b2 = last ? nB : cB + (size_t)(t + 2) * kstep;
            const char* a3 = a2 + kstep; const char* b3 = b2 + kstep;
            if (last && has_next) S.a_ready(nxt);
            PG8_LDB(B0, 0, 0); PG8_SCHED; PG8_LDA(At, 0, 0); PG8_STAGE(PG8_SA(1, 1), a1 + hstep, voffA);
            PG8_WAIT_L(8); PG8_BAR; PG8_WAIT_L(0); PG8_MMA(0, 0, At, B0); PG8_BAR; PG8_SCHED;
            PG8_LDB(B1, 0, 1); PG8_STAGE(PG8_SB(0, 0), b2, voffB);
            PG8_BAR; PG8_WAIT_L(0); PG8_MMA(0, 1, At, B1); PG8_BAR;
            PG8_LDA(At, 0, 1); PG8_STAGE(PG8_SA(0, 0), a2, voffA);
            PG8_BAR; PG8_WAIT_L(0); PG8_MMA(1, 0, At, B0); PG8_BAR; PG8_SCHED;
            PG8_STAGE(PG8_SB(0, 1), b2 + hstep, voffB);
            PG8_WAIT_V(6); PG8_BAR; PG8_MMA(1, 1, At, B1); PG8_BAR;
            PG8_LDB(B0, 1, 0); PG8_SCHED; PG8_LDA(At, 1, 0); PG8_STAGE(PG8_SA(0, 1), a2 + hstep, voffA);
            PG8_WAIT_L(8); PG8_BAR; PG8_WAIT_L(0); PG8_MMA(0, 0, At, B0); PG8_BAR; PG8_SCHED;
            PG8_LDB(B1, 1, 1); PG8_STAGE(PG8_SB(1, 0), b3, voffB);
            PG8_BAR; PG8_WAIT_L(0); PG8_MMA(0, 1, At, B1); PG8_BAR;
            PG8_LDA(At, 1, 1); PG8_STAGE(PG8_SA(1, 0), a3, voffA);
            PG8_BAR; PG8_WAIT_L(0); PG8_MMA(1, 0, At, B0); PG8_BAR; PG8_SCHED;
            PG8_STAGE(PG8_SB(1, 1), b3 + hstep, voffB);
            PG8_WAIT_V(6); PG8_BAR; PG8_MMA(1, 1, At, B1); PG8_BAR;
        }
        PG8_STAMP();
        if constexpr (!Epi::AFTER_DRAIN) { E(acc, cur, wr, wc, fr, fq); S.done(cur); }
        PG8_STAMP();
        if (!has_next) break;
#pragma unroll
        for (int a = 0; a < 2; ++a)
#pragma unroll
            for (int b = 0; b < 2; ++b)
#pragma unroll
                for (int m = 0; m < 4; ++m)
#pragma unroll
                    for (int n = 0; n < 2; ++n) acc[a][b][m][n] = (f32x4){0.f, 0.f, 0.f, 0.f};
        cur = nxt; cA = nA; cB = nB; ++ui;
    }
    PG8_WAIT_V(0);
    if (wr == 0) PG8_BAR;
    PG8_BAR;
    if constexpr (Epi::AFTER_DRAIN) { E.fused(acc, cur, wr, wc, fr, fq, lds, wid, lane); S.done(cur); }
    PG8_STAMP();
    if (STAMP && wid == 0) { stamps[lane] = lane < nts ? (((unsigned long long)(unsigned)ts_hi << 32) | (unsigned)ts_lo) : 0ull;
        if (lane == 62) stamps[62] = rt_entry; if (lane == 63) stamps[63] = (unsigned long long)wall_clock64(); }
#undef PG8_STAMP
#undef PG8_SA
#undef PG8_SB
#undef PG8_STAGE
#undef PG8_LDA
#undef PG8_LDB
#undef PG8_MMA
#undef PG8_WAIT_V
#undef PG8_WAIT_L
#undef PG8_BAR
#undef PG8_SCHED
}
}
using namespace pg8;
#ifndef DBG_SYS
#define DBG_SYS 1.0f
#endif
#ifndef DBG_KRW
#define DBG_KRW 1.0f
#endif
#ifndef DBG_KML
#define DBG_KML 1.0f
#endif
#ifndef DBG_SY
#define DBG_SY 1.0f
#endif
#ifndef DBG_SR
#define DBG_SR 1.0f
#endif
#ifndef DBG_SM
#define DBG_SM 1.0f
#endif
typedef unsigned u32x2 __attribute__((ext_vector_type(2)));

constexpr int D = 2048, FF = 5504;
constexpr int NPR = 32768, NREAL = 33280, MA = 33536, MC = 33280, MA_REAL = 33296;
constexpr int PLD = 7680, P_IF = 3360, P_QK = 3584, P_V = 5632, P_O = 6656;
enum { I_XP = 0, I_XS, I_SSHIFT, I_SWKV, I_SCONV, I_SC, I_SN, I_SM, I_META, I_F1N, I_F1G, I_F1U, I_F1D, I_MIXN, I_WIN, I_MU, I_W0, I_W2, I_A0, I_A2, I_G2, I_KK, I_KA, I_RK,
       I_LNW, I_LNB, I_CW, I_CB, I_IB, I_FB, I_MNW, I_BRRW, I_BRML, I_WOUT, I_F2N, I_F2G, I_F2U, I_F2D, I_FN, N_IN };
constexpr size_t O_YP = 0, O_YS = 67108864, O_PSHIFT = 68157440, O_PWKV = O_PSHIFT + 26880, O_PCONV = O_PWKV + 524288, O_PC = O_PCONV + 49152, O_PN = O_PC + 2097152,
                 O_PM = O_PN + 8192, O_SSHIFT = O_PM + 32, O_SWKV = O_SSHIFT + 107520, O_SCONV = O_SWKV + 2097152, O_SC = O_SCONV + 196608, O_SN = O_SC + 8388608,
                 O_SM = O_SN + 32768, O_END = O_SM + 128;
constexpr size_t al256(size_t x) { return (x + 255) & ~size_t(255); }
constexpr size_t WS_XINM = 4096;
constexpr size_t WS_XMETA = WS_XINM + 256 * 2048 * 4;
constexpr size_t WS_IF = WS_XMETA + 256 * 2048 * 4;
constexpr size_t WS_WGU = al256(WS_IF + (size_t)MA * 8 * 4);
constexpr size_t WS_WD = WS_WGU + (size_t)11008 * 2048 * 2;
constexpr size_t WS_WIN = WS_WD + (size_t)2048 * 5504 * 2;
constexpr size_t WS_WGATE = WS_WIN + (size_t)7680 * 2048 * 2;
constexpr size_t WS_WBRRW = WS_WGATE + (size_t)4096 * 2048 * 2;
constexpr size_t WS_WBRML = WS_WBRRW + (size_t)2048 * 1024 * 2;
constexpr size_t WS_WOUT = WS_WBRML + (size_t)2048 * 1024 * 2;
constexpr size_t WS_W2T = WS_WOUT + (size_t)2048 * 2048 * 2;
constexpr size_t WS_A2T = WS_W2T + 1024 * 64 * 2;
constexpr size_t WS_G2T = WS_A2T + 1024 * 64 * 2;
constexpr size_t WS_H = al256(WS_G2T + 1024 * 160 * 2);
constexpr size_t WS_YRW = WS_H + (size_t)MA * 2048 * 2;
constexpr size_t WS_YML = WS_YRW + (size_t)MC * 1024 * 2;
constexpr size_t WS_P = WS_YML + (size_t)MC * 1024 * 2;
constexpr size_t WS_END = WS_P + (size_t)MA * PLD * 2;
constexpr int LDS_BYTES = 160 * 1024;

struct Args { const float* in[N_IN]; float* out; unsigned char* ws; };

typedef __bf16 bf16n2 __attribute__((ext_vector_type(2)));
typedef float f32n2 __attribute__((ext_vector_type(2)));
DI unsigned pk2(float lo, float hi) { const f32n2 v = {lo, hi}; return __builtin_bit_cast(unsigned, __builtin_convertvector(v, bf16n2)); }
DI float bf_lo(unsigned u) { return __uint_as_float(u << 16); }
DI float bf_hi(unsigned u) { return __uint_as_float(u & 0xffff0000u); }
DI float sigm(float x) { return __builtin_amdgcn_rcpf(1.f + __expf(-x)); }
DI float wave_sum(float v) {
#pragma unroll
    for (int o = 1; o < 64; o <<= 1) v += __shfl_xor(v, o);
    return v;
}
#define LDS_WAIT() asm volatile("s_waitcnt lgkmcnt(0)" ::: "memory")
template <int CTRL> DI float dppf(float s) { return __builtin_bit_cast(float, __builtin_amdgcn_update_dpp(0, __builtin_bit_cast(int, s), CTRL, 0xF, 0xF, true)); }
DI float sum8(float s) { s += dppf<0xB1>(s); s += dppf<0x4E>(s); s += dppf<0x141>(s); return s; }
DI float sum16(float s) { s = sum8(s); s += dppf<0x140>(s); return s; }
DI void unpack8(const u32x4 v, float (&f)[8]) { f[0] = bf_lo(v.x); f[1] = bf_hi(v.x); f[2] = bf_lo(v.y); f[3] = bf_hi(v.y); f[4] = bf_lo(v.z); f[5] = bf_hi(v.z); f[6] = bf_lo(v.w); f[7] = bf_hi(v.w); }

struct EpiGU {
    static constexpr bool PERM = true, AFTER_DRAIN = false;
    bf16_t* O;
    DI void operator()(const f32x4 (&acc)[2][2][4][2], const Unit& u, int wr, int wc, int fr, int fq) const {
        const int row0 = u.pm * 256 + wr * 64 + fr, col0 = u.pn * 128 + wc * 32 + 8 * fq;
#pragma unroll
        for (int ai = 0; ai < 2; ++ai)
#pragma unroll
            for (int m = 0; m < 4; ++m) {
                bf16_t* rowp = O + (size_t)(row0 + ai * 128 + m * 16) * FF + col0;
                float v[8];
#pragma unroll
                for (int n = 0; n < 2; ++n)
#pragma unroll
                    for (int j = 0; j < 4; ++j) { const float g = acc[ai][0][m][n][j], up = acc[ai][1][m][n][j]; v[n * 4 + j] = g * sigm(g) * up; }
                u32x4 w; w.x = pk2(v[0], v[1]); w.y = pk2(v[2], v[3]); w.z = pk2(v[4], v[5]); w.w = pk2(v[6], v[7]);
                *(u32x4*)rowp = w;
            }
    }
};
struct EpiDown {
    static constexpr bool PERM = false, AFTER_DRAIN = false;
    const float *in0, *in1, *in2; float *o0, *o2;
    DI void operator()(const f32x4 (&acc)[2][2][4][2], const Unit& u, int wr, int wc, int fr, int fq) const {
        const float* ib = u.pm < 128 ? in0 + (size_t)u.pm * 256 * D : (u.pm < 130 ? in1 + (size_t)(u.pm - 128) * 256 * D : in2);
        float* ob = u.pm < 130 ? o0 + (size_t)u.pm * 256 * D : o2;
        const int rl0 = wr * 64 + fr, col0 = u.pn * 256 + wc * 32 + 4 * fq;
#pragma unroll
        for (int ai = 0; ai < 2; ++ai)
#pragma unroll
            for (int m = 0; m < 4; ++m) {
                const size_t off = (size_t)(rl0 + ai * 128 + m * 16) * D + col0;
#pragma unroll
                for (int bj = 0; bj < 2; ++bj)
#pragma unroll
                    for (int n = 0; n < 2; ++n) { const f32x4 xi = *(const f32x4*)(ib + off + bj * 128 + n * 16); *(f32x4*)(ob + off + bj * 128 + n * 16) = xi + 0.5f * acc[ai][bj][m][n]; }
            }
    }
};
struct EpiProj {
    static constexpr bool PERM = true, AFTER_DRAIN = false;
    bf16_t* O; float* IFp;
    DI void operator()(const f32x4 (&acc)[2][2][4][2], const Unit& u, int wr, int wc, int fr, int fq) const {
        const int row0 = u.pm * 256 + wr * 64 + fr, col0 = u.pn * 256 + wc * 32 + 8 * fq;
        const bool ifl = (u.pn == 13) && (wc == 1) && (fq == 0);
#pragma unroll
        for (int ai = 0; ai < 2; ++ai)
#pragma unroll
            for (int m = 0; m < 4; ++m) {
                const int r = row0 + ai * 128 + m * 16;
                bf16_t* rowp = O + (size_t)r * PLD + col0;
#pragma unroll
                for (int bj = 0; bj < 2; ++bj) { const f32x4 v0 = acc[ai][bj][m][0], v1 = acc[ai][bj][m][1];
                    u32x4 w; w.x = pk2(v0[0], v0[1]); w.y = pk2(v0[2], v0[3]); w.z = pk2(v1[0], v1[1]); w.w = pk2(v1[2], v1[3]);
                    *(u32x4*)(rowp + bj * 128) = w; }
                if (ifl) { *(f32x4*)(IFp + (size_t)r * 8) = acc[ai][0][m][0]; *(f32x4*)(IFp + (size_t)r * 8 + 4) = acc[ai][0][m][1]; }
            }
    }
};
struct EpiGate {
    static constexpr bool PERM = true, AFTER_DRAIN = false;
    bf16_t* O;
    DI void operator()(const f32x4 (&acc)[2][2][4][2], const Unit& u, int wr, int wc, int fr, int fq) const {
        const int row0 = u.pm * 256 + wr * 64 + fr, col0 = u.pn * 256 + wc * 32 + 8 * fq;
#pragma unroll
        for (int ai = 0; ai < 2; ++ai)
#pragma unroll
            for (int m = 0; m < 4; ++m) {
                bf16_t* rowp = O + (size_t)(row0 + ai * 128 + m * 16) * 4096 + col0;
#pragma unroll
                for (int bj = 0; bj < 2; ++bj) { const f32x4 v0 = acc[ai][bj][m][0], v1 = acc[ai][bj][m][1];
                    u32x4 w; w.x = pk2(sigm(v0[0]), sigm(v0[1])); w.y = pk2(sigm(v0[2]), sigm(v0[3])); w.z = pk2(sigm(v1[0]), sigm(v1[1])); w.w = pk2(sigm(v1[2]), sigm(v1[3]));
                    *(u32x4*)(rowp + bj * 128) = w; }
            }
    }
};
template <bool FIRST> struct EpiBr {
    static constexpr bool PERM = true, AFTER_DRAIN = false;
    const bf16_t* G; bf16_t* O; int goff;
    DI void operator()(const f32x4 (&acc)[2][2][4][2], const Unit& u, int wr, int wc, int fr, int fq) const {
        const int row0 = u.pm * 256 + wr * 64 + fr, col0 = u.pn * 256 + wc * 32 + 8 * fq;
#pragma unroll
        for (int ai = 0; ai < 2; ++ai)
#pragma unroll
            for (int m = 0; m < 4; ++m) {
                const int r = row0 + ai * 128 + m * 16;
#pragma unroll
                for (int bj = 0; bj < 2; ++bj) {
                    float g[8], o[8];
                    unpack8(*(const u32x4*)(G + (size_t)r * 4096 + goff + col0 + bj * 128), g);
                    bf16_t* op = O + (size_t)r * D + col0 + bj * 128;
                    if (FIRST) {
#pragma unroll
                        for (int j = 0; j < 8; ++j) o[j] = 0.f;
                    } else unpack8(*(const u32x4*)op, o);
#pragma unroll
                    for (int n = 0; n < 2; ++n)
#pragma unroll
                        for (int j = 0; j < 4; ++j) o[n * 4 + j] += (FIRST ? DBG_KRW : DBG_KML) * g[n * 4 + j] * acc[ai][bj][m][n][j];
                    u32x4 w; w.x = pk2(o[0], o[1]); w.y = pk2(o[2], o[3]); w.z = pk2(o[4], o[5]); w.w = pk2(o[6], o[7]);
                    *(u32x4*)op = w;
                }
            }
    }
};
struct EpiOut {
    static constexpr bool PERM = false, AFTER_DRAIN = false;
    float* X;
    DI void operator()(const f32x4 (&acc)[2][2][4][2], const Unit& u, int wr, int wc, int fr, int fq) const {
        const int row0 = u.pm * 256 + wr * 64 + fr, col0 = u.pn * 256 + wc * 32 + 4 * fq;
#pragma unroll
        for (int ai = 0; ai < 2; ++ai)
#pragma unroll
            for (int m = 0; m < 4; ++m) {
                float* rowp = X + (size_t)(row0 + ai * 128 + m * 16) * D + col0;
#pragma unroll
                for (int bj = 0; bj < 2; ++bj)
#pragma unroll
                    for (int n = 0; n < 2; ++n) { f32x4* p = (f32x4*)(rowp + bj * 128 + n * 16); *p = *p + acc[ai][bj][m][n]; }
            }
    }
};
template <class Epi> DI void run_gemm(LAS unsigned char* lds, const bf16_t* A, const bf16_t* Bt, int M, int N, int K, const Epi& E) {
    Gemm g; g.A = A; g.Bt = Bt; g.M = M; g.N = N; g.K = K;
    StaticOrder S; S.init(M, N, (int)gridDim.x, (int)blockIdx.x);
    gemm_phase<Epi, StaticOrder, false>(lds, g, S, E, nullptr);
}

DI void tr_item(const float* W, int K, int Nsrc, bf16_t* WT, int k0, int n0d, int n0s, int nvalid, LAS float* scr, int lane) {
    const int c = lane & 31;
#pragma unroll 8
    for (int i = 0; i < 32; ++i) { const int kk = 2 * i + (lane >> 5); scr[kk * 33 + c] = (c < nvalid) ? W[(size_t)(k0 + kk) * Nsrc + n0s + c] : 0.f; }
    LDS_WAIT();
    const int ch = lane & 7;
#pragma unroll
    for (int j = 0; j < 4; ++j) { const int n = (lane >> 3) + 8 * j; const LAS float* s = scr + (8 * ch) * 33 + n;
        u32x4 o; o.x = pk2(s[0 * 33], s[1 * 33]); o.y = pk2(s[2 * 33], s[3 * 33]); o.z = pk2(s[4 * 33], s[5 * 33]); o.w = pk2(s[6 * 33], s[7 * 33]);
        *(u32x4*)(WT + (size_t)(n0d + n) * K + k0 + 8 * ch) = o; }
    LDS_WAIT();
}
DI void conv_ffn(const Args& a, LAS unsigned char* lds, int which  , int gw, int ngw, int wave, int lane) {
    LAS float* scr = (LAS float*)(lds + wave * 8704);
    const float* Wg = a.in[which ? I_F2G : I_F1G]; const float* Wu = a.in[which ? I_F2U : I_F1U]; const float* Wd = a.in[which ? I_F2D : I_F1D];
    bf16_t* WGU = (bf16_t*)(a.ws + WS_WGU); bf16_t* WD = (bf16_t*)(a.ws + WS_WD);
    constexpr int IT_GU = 32 * 344, IT_D = 86 * 64;
    for (int it = gw; it < IT_GU + IT_D; it += ngw) {
        if (it < IT_GU) { const int kb = it / 344, gi = it % 344, n0d = gi * 32, pn = n0d >> 8, half = (n0d >> 7) & 1, idx = n0d & 127;
            tr_item(half ? Wu : Wg, 2048, FF, WGU, kb * 64, n0d, pn * 128 + idx, 32, scr, lane); }
        else { const int r = it - IT_GU, kb = r / 64, gi = r % 64; tr_item(Wd, FF, 2048, WD, kb * 64, gi * 32, gi * 32, 32, scr, lane); }
    }
}
DI void conv_rest(const Args& a, LAS unsigned char* lds, int gw, int ngw, int wave, int lane) {
    LAS float* scr = (LAS float*)(lds + wave * 8704);
    constexpr int IT_IN = 32 * 240, IT_GATE = 32 * 128, IT_BR = 16 * 64, IT_OUT = 32 * 64;
    for (int it = gw; it < IT_IN + IT_GATE + 2 * IT_BR + IT_OUT; it += ngw) {
        int r = it;
        if (r < IT_IN) { const int kb = r / 240, gi = r % 240, n0d = gi * 32; int n0s, nv;
            if (gi < 105) { n0s = n0d; nv = 32; } else if (gi == 105) { n0s = 7456; nv = 8; } else if (gi < 112) { n0s = 0; nv = 0; } else { n0s = 3360 + (n0d - 3584); nv = 32; }
            tr_item(a.in[I_WIN], 2048, 11560, (bf16_t*)(a.ws + WS_WIN), kb * 64, n0d, n0s, nv, scr, lane); continue; }
        r -= IT_IN;
        if (r < IT_GATE) { const int kb = r / 128, gi = r % 128; tr_item(a.in[I_WIN], 2048, 11560, (bf16_t*)(a.ws + WS_WGATE), kb * 64, gi * 32, 7464 + gi * 32, 32, scr, lane); continue; }
        r -= IT_GATE;
        if (r < IT_BR) { const int kb = r / 64, gi = r % 64; tr_item(a.in[I_BRRW], 1024, 2048, (bf16_t*)(a.ws + WS_WBRRW), kb * 64, gi * 32, gi * 32, 32, scr, lane); continue; }
        r -= IT_BR;
        if (r < IT_BR) { const int kb = r / 64, gi = r % 64; tr_item(a.in[I_BRML], 1024, 2048, (bf16_t*)(a.ws + WS_WBRML), kb * 64, gi * 32, gi * 32, 32, scr, lane); continue; }
        r -= IT_BR;
        { const int kb = r / 64, gi = r % 64; tr_item(a.in[I_WOUT], 2048, 2048, (bf16_t*)(a.ws + WS_WOUT), kb * 64, gi * 32, gi * 32, 32, scr, lane); }
    }
}
DI void rms_row_bf16(const float* xr, const float* g, bf16_t* orow, int lane) {
    f32x4 v[8]; float s = 0.f;
#pragma unroll
    for (int j = 0; j < 8; ++j) { v[j] = ((const f32x4*)xr)[lane + 64 * j]; s += (v[j].x * v[j].x + v[j].y * v[j].y) + (v[j].z * v[j].z + v[j].w * v[j].w); }
    const float r = rsqrtf(wave_sum(s) * (1.f / D) + 1e-6f);
#pragma unroll
    for (int j = 0; j < 8; ++j) { const f32x4 gg = ((const f32x4*)g)[lane + 64 * j]; u32x2 o; o.x = pk2(v[j].x * r * gg.x, v[j].y * r * gg.y); o.y = pk2(v[j].z * r * gg.z, v[j].w * r * gg.w);
        ((u32x2*)orow)[lane + 64 * j] = o; }
}
DI void rms_row_f32(float* xr, const float* g, int lane, float dbg = 1.f) {
    f32x4 v[8]; float s = 0.f;
#pragma unroll
    for (int j = 0; j < 8; ++j) { v[j] = ((const f32x4*)xr)[lane + 64 * j]; s += (v[j].x * v[j].x + v[j].y * v[j].y) + (v[j].z * v[j].z + v[j].w * v[j].w); }
    const float r = rsqrtf(wave_sum(s) * (1.f / D) + 1e-6f);
#pragma unroll
    for (int j = 0; j < 8; ++j) { const f32x4 gg = ((const f32x4*)g)[lane + 64 * j]; ((f32x4*)xr)[lane + 64 * j] = v[j] * (r * DBG_SY * dbg) * gg; }
}
DI int seq_row(int kind, int b, int t) { return kind ? (NPR + b * 16 + t) : (t < 16 ? NREAL + t : b * 4096 + t - 16); }
DI void rwkv_task(const Args& a, LAS unsigned char* lds, int kind, int b, int h) {
    int tid_ = threadIdx.x; asm volatile("" : "+v"(tid_));
    const int tid = tid_, wave = tid >> 6, lane = tid & 63, fr = lane & 15, fq = lane >> 4;
    LAS float* Wd = (LAS float*)lds; LAS float* Av = Wd + 2048; LAS float* Bv = Av + 2048; LAS float* Kv = Bv + 2048; LAS float* Rv = Kv + 2048; LAS float* Vv = Rv + 2048;
    LAS float* Gv = Vv + 2048; LAS float* Yv = Gv + 2048; LAS float* bon = Yv + 2048;
    LAS bf16_t* Alw = (LAS bf16_t*)(bon + 64); LAS bf16_t* Ala = Alw + 32 * 72; LAS bf16_t* Alg = Ala + 32 * 72;
    const bf16_t* P = (const bf16_t*)(a.ws + WS_P);
    const bf16_t* w2T = (const bf16_t*)(a.ws + WS_W2T); const bf16_t* a2T = (const bf16_t*)(a.ws + WS_A2T); const bf16_t* g2T = (const bf16_t*)(a.ws + WS_G2T);
    bf16_t* YRW = (bf16_t*)(a.ws + WS_YRW);
    const int T = kind ? 16 : 4112;
    const int sv = tid >> 3, kq = tid & 7;
    float S[8];
    if (kind) { const float* s0 = a.in[I_SWKV] + ((size_t)(b * 16 + h) * 64 + sv) * 64 + kq * 8;
#pragma unroll
        for (int i = 0; i < 8; ++i) S[i] = s0[i]; }
    else {
#pragma unroll
        for (int i = 0; i < 8; ++i) S[i] = 0.f; }
    const int ej = tid >> 4, ep = tid & 15, ec = ep * 4, ehc = h * 64 + ec;
    for (int t0 = 0; t0 < T;) {
        const int Lc = (t0 == 0) ? 16 : 32;
        for (int idx = tid; idx < Lc * 60; idx += 512) {
            const int j = idx / 60, g = idx % 60;
            int col;
            if (g < 24) col = (g >> 3) * 1024 + h * 64 + (g & 7) * 8; else col = 3072 + (g - 24) * 8;
            const int t = t0 + j;
            float cur[8], prv[8];
            unpack8(*(const u32x4*)(P + (size_t)seq_row(kind, b, t) * PLD + col), cur);
            if (t > 0) unpack8(*(const u32x4*)(P + (size_t)seq_row(kind, b, t - 1) * PLD + col), prv);
            else if (kind) { const float* sp = a.in[I_SSHIFT] + (size_t)b * 3360 + col;
#pragma unroll
                for (int i = 0; i < 8; ++i) prv[i] = sp[i]; }
            else {
#pragma unroll
                for (int i = 0; i < 8; ++i) prv[i] = 0.f; }
            const float* mu = a.in[I_MU] + col;
            float u[8];
#pragma unroll
            for (int i = 0; i < 8; ++i) u[i] = cur[i] + mu[i] * (prv[i] - cur[i]);
            if (g < 24) { LAS float* dst = (g < 8 ? Rv : (g < 16 ? Kv : Vv)) + j * 64 + (g & 7) * 8;
                *(LAS f32x4*)dst = (f32x4){u[0], u[1], u[2], u[3]}; *(LAS f32x4*)(dst + 4) = (f32x4){u[4], u[5], u[6], u[7]}; }
            else {
                LAS bf16_t* dst;
                if (g < 32) { dst = Alw + j * 72 + (g - 24) * 8;
#pragma unroll
                    for (int i = 0; i < 8; ++i) u[i] = tanhf(u[i]); }
                else if (g < 40) dst = Ala + j * 72 + (g - 32) * 8;
                else { dst = Alg + j * 168 + (g - 40) * 8;
#pragma unroll
                    for (int i = 0; i < 8; ++i) u[i] = sigm(u[i]); }
                u32x4 w; w.x = pk2(u[0], u[1]); w.y = pk2(u[2], u[3]); w.z = pk2(u[4], u[5]); w.w = pk2(u[6], u[7]);
                *(LAS u32x4*)dst = w;
            }
        }
        __syncthreads();
        {
            const int tr = wave >> 2, tc = wave & 3;
            const int arow = tr * 16 + fr, bcol = h * 64 + tc * 16 + fr;
            f32x4 zw = {0.f, 0.f, 0.f, 0.f}, za = zw, zg = zw;
#pragma unroll
            for (int ks = 0; ks < 2; ++ks) {
                const bf16x8 A1 = *(const LAS bf16x8*)(Alw + arow * 72 + ks * 32 + fq * 8), B1 = *(const bf16x8*)(w2T + (size_t)bcol * 64 + ks * 32 + fq * 8);
                zw = __builtin_amdgcn_mfma_f32_16x16x32_bf16(A1, B1, zw, 0, 0, 0);
                const bf16x8 A2 = *(const LAS bf16x8*)(Ala + arow * 72 + ks * 32 + fq * 8), B2 = *(const bf16x8*)(a2T + (size_t)bcol * 64 + ks * 32 + fq * 8);
                za = __builtin_amdgcn_mfma_f32_16x16x32_bf16(A2, B2, za, 0, 0, 0);
            }
#pragma unroll
            for (int ks = 0; ks < 5; ++ks) {
                const bf16x8 A3 = *(const LAS bf16x8*)(Alg + arow * 168 + ks * 32 + fq * 8), B3 = *(const bf16x8*)(g2T + (size_t)bcol * 160 + ks * 32 + fq * 8);
                zg = __builtin_amdgcn_mfma_f32_16x16x32_bf16(A3, B3, zg, 0, 0, 0);
            }
#pragma unroll
            for (int j = 0; j < 4; ++j) { const int o = (tr * 16 + fq * 4 + j) * 64 + tc * 16 + fr; Wd[o] = zw[j]; Av[o] = za[j]; Gv[o] = zg[j]; }
        }
        __syncthreads();
        if (ej < Lc) {
            const int o = ej * 64 + ec;
            const f32x4 zw = *(LAS f32x4*)(Wd + o), za = *(LAS f32x4*)(Av + o), uk = *(LAS f32x4*)(Kv + o), ur = *(LAS f32x4*)(Rv + o);
            const f32x4 w0 = *(const f32x4*)(a.in[I_W0] + ehc), a0 = *(const f32x4*)(a.in[I_A0] + ehc), kkw = *(const f32x4*)(a.in[I_KK] + ehc), kaw = *(const f32x4*)(a.in[I_KA] + ehc),
                        rk = *(const f32x4*)(a.in[I_RK] + ehc);
            f32x4 dec, av, kkv, kp; float ss = 0.f, bd = 0.f;
#pragma unroll
            for (int i = 0; i < 4; ++i) {
                const float e = sigm(zw[i] + w0[i]) * 0.60653066f;
                dec[i] = __expf(-e);
                av[i] = sigm(a0[i] + za[i]);
                kkv[i] = uk[i] * kkw[i]; ss += kkv[i] * kkv[i];
                kp[i] = uk[i] * (1.f + (av[i] - 1.f) * kaw[i]);
                bd += ur[i] * kp[i] * rk[i];
            }
            ss = sum16(ss); bd = sum16(bd);
            const float inv = 1.f / fmaxf(sqrtf(ss), 1e-12f);
            f32x4 na, nb;
#pragma unroll
            for (int i = 0; i < 4; ++i) { const float kk = kkv[i] * inv; na[i] = -kk; nb[i] = kk * av[i]; }
            *(LAS f32x4*)(Wd + o) = dec; *(LAS f32x4*)(Av + o) = na; *(LAS f32x4*)(Bv + o) = nb; *(LAS f32x4*)(Kv + o) = kp;
            if (ep == 0) bon[ej] = bd;
        }
        __syncthreads();
#pragma unroll 2
        for (int j = 0; j < Lc; ++j) {
            const int o = j * 64 + kq * 8;
            const f32x4 w0 = *(LAS f32x4*)(Wd + o), w1 = *(LAS f32x4*)(Wd + o + 4), a0 = *(LAS f32x4*)(Av + o), a1 = *(LAS f32x4*)(Av + o + 4), b0 = *(LAS f32x4*)(Bv + o), b1 = *(LAS f32x4*)(Bv + o + 4),
                        k0 = *(LAS f32x4*)(Kv + o), k1 = *(LAS f32x4*)(Kv + o + 4), r0 = *(LAS f32x4*)(Rv + o), r1 = *(LAS f32x4*)(Rv + o + 4);
            const float vv = Vv[j * 64 + sv];
            float sa = (S[0] * a0[0] + S[1] * a0[1]) + (S[2] * a0[2] + S[3] * a0[3]) + (S[4] * a1[0] + S[5] * a1[1]) + (S[6] * a1[2] + S[7] * a1[3]);
            sa = sum8(sa);
#pragma unroll
            for (int i = 0; i < 4; ++i) { S[i] = S[i] * w0[i] + sa * b0[i] + vv * k0[i]; S[4 + i] = S[4 + i] * w1[i] + sa * b1[i] + vv * k1[i]; }
            float y = (S[0] * r0[0] + S[1] * r0[1]) + (S[2] * r0[2] + S[3] * r0[3]) + (S[4] * r1[0] + S[5] * r1[1]) + (S[6] * r1[2] + S[7] * r1[3]);
            y = sum8(y);
            if (kq == 0) Yv[j * 64 + sv] = y;
        }
        __syncthreads();
        if (ej < Lc) {
            const int row = seq_row(kind, b, t0 + ej);
            if (row < NREAL) {
                const int o = ej * 64 + ec;
                const f32x4 y = *(LAS f32x4*)(Yv + o), vv = *(LAS f32x4*)(Vv + o), gg = *(LAS f32x4*)(Gv + o);
                const float mean = sum16((y[0] + y[1]) + (y[2] + y[3])) * (1.f / 64.f);
                const f32x4 d = y - mean;
                const float var = sum16((d[0] * d[0] + d[1] * d[1]) + (d[2] * d[2] + d[3] * d[3])) * (1.f / 64.f);
                const float rs = rsqrtf(var + 64e-5f), bo = bon[ej];
                const f32x4 lw = *(const f32x4*)(a.in[I_LNW] + ehc), lb = *(const f32x4*)(a.in[I_LNB] + ehc);
                f32x4 o4;
#pragma unroll
                for (int i = 0; i < 4; ++i) o4[i] = (d[i] * rs * lw[i] + lb[i] + bo * vv[i]) * gg[i];
                u32x2 w; w.x = pk2(o4[0], o4[1]); w.y = pk2(o4[2], o4[3]);
                *(u32x2*)(YRW + (size_t)row * 1024 + ehc) = w;
            }
        }
        __syncthreads();
        t0 += Lc;
    }
    {
        float* so = a.out + (kind ? O_SWKV : O_PWKV) + ((size_t)(b * 16 + h) * 64 + sv) * 64 + kq * 8;
        *(f32x4*)so = (f32x4){S[0], S[1], S[2], S[3]} * DBG_SR; *(f32x4*)(so + 4) = (f32x4){S[4], S[5], S[6], S[7]} * DBG_SR;
        if (h == 0) {
            float* sh = a.out + (kind ? O_SSHIFT : O_PSHIFT) + (size_t)b * 3360;
            const bf16_t* pr = P + (size_t)seq_row(kind, b, T - 1) * PLD;
            for (int c = tid; c < 3360; c += 512) sh[c] = __uint_as_float((unsigned)pr[c] << 16);
        }
    }
}
DI int off512(int row, int chunk) { return row * 512 + ((chunk ^ (row & 15)) << 4); }
DI int off128(int row, int chunk) { return row * 128 + ((chunk ^ ((row >> 1) & 7)) << 4); }
DI u32x4 ml_qk_row(const Args& a, const bf16_t* P, int kind, int b, int T, int tg, int chan) {
    u32x4 z = {0u, 0u, 0u, 0u};
    if (tg >= T) return z;
    if (tg < 0) {
        if (!kind) return z;
        const float* sp = a.in[I_SCONV] + ((size_t)b * 3 + (3 + tg)) * 2048 + chan;
        u32x4 w; w.x = pk2(sp[0], sp[1]); w.y = pk2(sp[2], sp[3]); w.z = pk2(sp[4], sp[5]); w.w = pk2(sp[6], sp[7]); return w;
    }
    return *(const u32x4*)(P + (size_t)seq_row(kind, b, tg) * PLD + P_QK + chan);
}
DI void mlstm_task(const Args& a, LAS unsigned char* lds, int kind, int b, int head, int vs) {
    int tid_ = threadIdx.x; asm volatile("" : "+v"(tid_));
    const int tid = tid_, wave = tid >> 6, lane = tid & 63, fr_ = lane & 15, fq_ = lane >> 4;
    LAS unsigned char* qs = lds; LAS unsigned char* ks = lds + 32768; LAS unsigned char* kT = lds + 65536; LAS unsigned char* vT = lds + 98304;
    LAS unsigned char* CbT = lds + 106496; LAS unsigned char* sP = lds + 139264;
    LAS float* nS = (LAS float*)(lds + 147456); LAS float* sc_c = nS + 256; LAS float* sc_M = sc_c + 64; LAS float* sc_win = sc_M + 64; LAS float* sc_enmq = sc_win + 64;
    LAS float* sc_wk = sc_enmq + 64; LAS float* denp = sc_wk + 64; LAS float* dinvS = denp + 128; LAS float* misc = dinvS + 64;
    const bf16_t* P = (const bf16_t*)(a.ws + WS_P); const float* IFp = (const float*)(a.ws + WS_IF); bf16_t* HM = (bf16_t*)(a.ws + WS_YML);
    const int T = kind ? 16 : 4112;
    const float ib = a.in[I_IB][head], fb = a.in[I_FB][head];
    f32x4 Cacc[2][4];
    {
        const int fr = fr_, fq = fq_;
        const float* C0 = a.in[I_SC] + (size_t)(b * 4 + head) * 65536 + vs * 64;
#pragma unroll
        for (int k2 = 0; k2 < 2; ++k2)
#pragma unroll
            for (int vt = 0; vt < 4; ++vt)
#pragma unroll
                for (int j = 0; j < 4; ++j) { const int key = (wave * 2 + k2) * 16 + fq * 4 + j, v = vt * 16 + fr; Cacc[k2][vt][j] = kind ? C0[(size_t)key * 256 + v] : 0.f; }
#pragma unroll
        for (int k2 = 0; k2 < 2; ++k2)
#pragma unroll
            for (int vt = 0; vt < 4; ++vt) { const int key0 = (wave * 2 + k2) * 16 + fq * 4, v = vt * 16 + fr; u32x2 w; w.x = pk2(Cacc[k2][vt][0], Cacc[k2][vt][1]); w.y = pk2(Cacc[k2][vt][2], Cacc[k2][vt][3]);
                *(LAS u32x2*)(CbT + off512(v, key0 >> 3) + (key0 & 7) * 2) = w; }
        if (tid < 256) nS[tid] = kind ? a.in[I_SN][(size_t)(b * 4 + head) * 256 + tid] : 0.f;
    }
    float m = kind ? a.in[I_SM][b * 4 + head] : 0.f;
    __syncthreads();
    for (int t0 = 0; t0 < T;) {
        const int L = (t0 == 0) ? 16 : 64;
        if (wave == 0) {
            const int t = lane; const bool valid = t < L; const int row = valid ? seq_row(kind, b, t0 + t) : 0;
            const float iv = valid ? IFp[(size_t)row * 8 + head] + ib : -INFINITY;
            const float x = valid ? IFp[(size_t)row * 8 + 4 + head] + fb : 0.f;
            const float lf = valid ? (fminf(x, 0.f) - log1pf(__expf(-fabsf(x)))) : 0.f;
            float bs = lf;
#pragma unroll
            for (int o = 1; o < 64; o <<= 1) { const float y = __shfl_up(bs, o); if (lane >= o) bs += y; }
            const float c = iv - bs;
            float pm = c;
#pragma unroll
            for (int o = 1; o < 64; o <<= 1) { const float y = __shfl_up(pm, o); if (lane >= o) pm = fmaxf(pm, y); }
            const float M = fmaxf(m, pm);
            const float M63 = __shfl(M, 63), b63 = __shfl(bs, 63);
            sc_c[t] = c; sc_M[t] = M; sc_win[t] = __expf(m - M); sc_enmq[t] = __expf(-(bs + M)); sc_wk[t] = __expf(c - M63);
            if (lane == 0) { misc[0] = __expf(m - M63); misc[1] = b63 + M63; }
        }
        __syncthreads();
#ifndef NO_B
        {
            const int cgp = tid & 63, pg = wave; const bool isk = cgp >= 32; const int kc = cgp & 31;
            const int chan = (isk ? 1024 : 0) + head * 256 + kc * 8;
            float cw[4][8], cb[8];
#pragma unroll
            for (int j = 0; j < 4; ++j)
#pragma unroll
                for (int i = 0; i < 8; ++i) cw[j][i] = a.in[I_CW][j * 2048 + chan + i];
#pragma unroll
            for (int i = 0; i < 8; ++i) cb[i] = a.in[I_CB][chan + i];
            float x0[8], x1[8], x2[8];
            unpack8(ml_qk_row(a, P, kind, b, T, t0 + pg * 8 - 3, chan), x0); unpack8(ml_qk_row(a, P, kind, b, T, t0 + pg * 8 - 2, chan), x1); unpack8(ml_qk_row(a, P, kind, b, T, t0 + pg * 8 - 1, chan), x2);
#pragma unroll 1
            for (int p = 0; p < 8; ++p) {
                const int tt = pg * 8 + p;
                float o[8], x3[8];
                unpack8(ml_qk_row(a, P, kind, b, T, t0 + tt, chan), x3);
#pragma unroll
                for (int i = 0; i < 8; ++i) { float s = cb[i] + cw[0][i] * x0[i] + cw[1][i] * x1[i] + cw[2][i] * x2[i] + cw[3][i] * x3[i]; s = s * sigm(s); if (isk) s *= 0.0625f; o[i] = (tt < L) ? s : 0.f; }
                u32x4 w; w.x = pk2(o[0], o[1]); w.y = pk2(o[2], o[3]); w.z = pk2(o[4], o[5]); w.w = pk2(o[6], o[7]);
                *(LAS u32x4*)((isk ? ks : qs) + off512(tt, kc)) = w;
                if (isk) {
                    const float wkp = sc_wk[tt];
#pragma unroll
                    for (int i = 0; i < 8; ++i) *(LAS unsigned short*)(kT + off128(kc * 8 + i, pg) + p * 2) = (unsigned short)(pk2(o[i] * wkp, 0.f) & 0xffffu);
                }
#pragma unroll
                for (int i = 0; i < 8; ++i) { x0[i] = x1[i]; x1[i] = x2[i]; x2[i] = x3[i]; }
            }
            const int pos = tid >> 3, c8 = tid & 7;
            u32x4 vv = {0u, 0u, 0u, 0u};
            if (pos < L) vv = *(const u32x4*)(P + (size_t)seq_row(kind, b, t0 + pos) * PLD + P_V + head * 256 + vs * 64 + c8 * 8);
            const unsigned vw[4] = {vv.x, vv.y, vv.z, vv.w};
#pragma unroll
            for (int i = 0; i < 8; ++i) { const int v = c8 * 8 + i; const unsigned short hv = (unsigned short)((i & 1) ? (vw[i >> 1] >> 16) : (vw[i >> 1] & 0xffffu));
                *(LAS unsigned short*)(vT + off128(v, pos >> 3) + (pos & 7) * 2) = hv; }
        }
#endif
        __syncthreads();
        {
            int fr = fr_, fq = fq_; asm volatile("" : "+v"(fr), "+v"(fq));
            const int tt_ = wave >> 1; const int t = tt_ * 16 + fr; const float Mt = sc_M[t];
            float rowsum = 0.f;
#pragma unroll
            for (int si = 0; si < 2; ++si) {
                const int st = (wave & 1) * 2 + si, s0 = st * 16 + fq * 4;
                u32x2 w = {0u, 0u};
                if (st <= tt_) {
                    f32x4 acc = {0.f, 0.f, 0.f, 0.f};
#pragma unroll
                    for (int kk = 0; kk < 8; ++kk) { const int ch = kk * 4 + fq;
                        const bf16x8 A = *(const LAS bf16x8*)(ks + off512(st * 16 + fr, ch)), B = *(const LAS bf16x8*)(qs + off512(t, ch));
                        acc = __builtin_amdgcn_mfma_f32_16x16x32_bf16(A, B, acc, 0, 0, 0); }
                    const f32x4 cs = *(const LAS f32x4*)(sc_c + s0);
                    float val[4];
#pragma unroll
                    for (int j = 0; j < 4; ++j) { val[j] = (s0 + j <= t) ? acc[j] * __expf(cs[j] - Mt) : 0.f; rowsum += val[j]; }
                    w.x = pk2(val[0], val[1]); w.y = pk2(val[2], val[3]);
                }
                *(LAS u32x2*)(sP + off128(t, s0 >> 3) + (s0 & 7) * 2) = w;
            }
            rowsum += __shfl_xor(rowsum, 16); rowsum += __shfl_xor(rowsum, 32);
            if (fq == 0) denp[(wave & 1) * 64 + t] = rowsum;
        }
        __syncthreads();
        {
            int tidx = tid; asm volatile("" : "+v"(tidx));
            const int t = tidx >> 3, part = tidx & 7; float qn = 0.f;
#pragma unroll
            for (int i = 0; i < 4; ++i) { const int c4 = part * 4 + i; float q8[8]; unpack8(*(const LAS u32x4*)(qs + off512(t, c4)), q8);
                const f32x4 n0 = *(const LAS f32x4*)(nS + c4 * 8), n1 = *(const LAS f32x4*)(nS + c4 * 8 + 4);
                qn += (q8[0] * n0[0] + q8[1] * n0[1]) + (q8[2] * n0[2] + q8[3] * n0[3]) + (q8[4] * n1[0] + q8[5] * n1[1]) + (q8[6] * n1[2] + q8[7] * n1[3]); }
            qn = sum8(qn);
            const float den = sc_win[t] * qn + denp[t] + denp[64 + t];
            if (part == 0) dinvS[t] = 1.f / fmaxf(fabsf(den), sc_enmq[t]);
        }
        __syncthreads();
        {
            int fr = fr_, fq = fq_; asm volatile("" : "+v"(fr), "+v"(fq));
            const int tt_ = wave >> 1; const int t = tt_ * 16 + fr;
            f32x4 a1[2], a2[2];
#pragma unroll
            for (int vi = 0; vi < 2; ++vi) { a1[vi] = (f32x4){0.f, 0.f, 0.f, 0.f}; a2[vi] = a1[vi]; }
#pragma unroll
            for (int kk = 0; kk < 8; ++kk) { const int ch = kk * 4 + fq; const bf16x8 B = *(const LAS bf16x8*)(qs + off512(t, ch));
#pragma unroll
                for (int vi = 0; vi < 2; ++vi) { const int vt = (wave & 1) * 2 + vi; const bf16x8 A = *(const LAS bf16x8*)(CbT + off512(vt * 16 + fr, ch)); a1[vi] = __builtin_amdgcn_mfma_f32_16x16x32_bf16(A, B, a1[vi], 0, 0, 0); } }
#pragma unroll
            for (int kk = 0; kk < 2; ++kk) { const int ch = kk * 4 + fq; const bf16x8 B = *(const LAS bf16x8*)(sP + off128(t, ch));
#pragma unroll
                for (int vi = 0; vi < 2; ++vi) { const int vt = (wave & 1) * 2 + vi; const bf16x8 A = *(const LAS bf16x8*)(vT + off128(vt * 16 + fr, ch)); a2[vi] = __builtin_amdgcn_mfma_f32_16x16x32_bf16(A, B, a2[vi], 0, 0, 0); } }
            if (t < L) {
                const int row = seq_row(kind, b, t0 + t);
                if (row < NREAL) {
                    const float win = sc_win[t], di = dinvS[t];
#pragma unroll
                    for (int vi = 0; vi < 2; ++vi) { const int vt = (wave & 1) * 2 + vi; u32x2 w;
                        w.x = pk2((win * a1[vi][0] + a2[vi][0]) * di, (win * a1[vi][1] + a2[vi][1]) * di); w.y = pk2((win * a1[vi][2] + a2[vi][2]) * di, (win * a1[vi][3] + a2[vi][3]) * di);
                        *(u32x2*)(HM + (size_t)row * 1024 + head * 256 + vs * 64 + vt * 16 + fq * 4) = w; }
                }
            }
        }
        __syncthreads();
        {
            int fr = fr_, fq = fq_, tidx = tid; asm volatile("" : "+v"(fr), "+v"(fq), "+v"(tidx));
            const float ast = misc[0], mnew = misc[1];
#pragma unroll
            for (int k2 = 0; k2 < 2; ++k2)
#pragma unroll
                for (int vt = 0; vt < 4; ++vt) Cacc[k2][vt] = Cacc[k2][vt] * ast;
#pragma unroll
            for (int kk = 0; kk < 2; ++kk) { const int ch = kk * 4 + fq;
                bf16x8 Bv[4];
#pragma unroll
                for (int vt = 0; vt < 4; ++vt) Bv[vt] = *(const LAS bf16x8*)(vT + off128(vt * 16 + fr, ch));
#pragma unroll
                for (int k2 = 0; k2 < 2; ++k2) { const bf16x8 A = *(const LAS bf16x8*)(kT + off128((wave * 2 + k2) * 16 + fr, ch));
#pragma unroll
                    for (int vt = 0; vt < 4; ++vt) Cacc[k2][vt] = __builtin_amdgcn_mfma_f32_16x16x32_bf16(A, Bv[vt], Cacc[k2][vt], 0, 0, 0); } }
#pragma unroll
            for (int k2 = 0; k2 < 2; ++k2)
#pragma unroll
                for (int vt = 0; vt < 4; ++vt) { const int key0 = (wave * 2 + k2) * 16 + fq * 4, v = vt * 16 + fr; u32x2 w; w.x = pk2(Cacc[k2][vt][0], Cacc[k2][vt][1]); w.y = pk2(Cacc[k2][vt][2], Cacc[k2][vt][3]);
                    *(LAS u32x2*)(CbT + off512(v, key0 >> 3) + (key0 & 7) * 2) = w; }
            if (tidx < 256) { float s = 0.f;
#pragma unroll
                for (int c = 0; c < 8; ++c) { float k8[8]; unpack8(*(const LAS u32x4*)(kT + off128(tidx, c)), k8); s += (k8[0] + k8[1]) + (k8[2] + k8[3]) + (k8[4] + k8[5]) + (k8[6] + k8[7]); }
                nS[tidx] = ast * nS[tidx] + s; }
            m = mnew;
        }
        __syncthreads();
        t0 += L;
    }
    {
        const int fr = fr_, fq = fq_;
        float* Co = a.out + (kind ? O_SC : O_PC) + (size_t)(b * 4 + head) * 65536 + vs * 64;
#pragma unroll
        for (int k2 = 0; k2 < 2; ++k2)
#pragma unroll
            for (int vt = 0; vt < 4; ++vt)
#pragma unroll
                for (int j = 0; j < 4; ++j) { const int key = (wave * 2 + k2) * 16 + fq * 4 + j, v = vt * 16 + fr; Co[(size_t)key * 256 + v] = Cacc[k2][vt][j] * DBG_SM; }
        if (vs == 0) {
            if (tid < 256) a.out[(kind ? O_SN : O_PN) + (size_t)(b * 4 + head) * 256 + tid] = nS[tid] * DBG_SM;
            if (tid == 0) a.out[(kind ? O_SM : O_PM) + b * 4 + head] = m * DBG_SM;
            if (head == 0) {
                float* co = a.out + (kind ? O_SCONV : O_PCONV) + (size_t)b * 3 * 2048;
                for (int i = tid; i < 3 * 2048; i += 512) { const int j = i >> 11, ch = i & 2047; co[i] = __uint_as_float((unsigned)P[(size_t)seq_row(kind, b, T - 3 + j) * PLD + P_QK + ch] << 16); }
            }
        }
    }
    __syncthreads();
}
template <class F> DI void simple_gemm(const bf16_t* A, const bf16_t* Bt, int M, int N, int K, int gw, int ngw, int lane, F&& epi) {
    const int fr = lane & 15, fq = lane >> 4, nt = N / 16;
    for (int tile = gw; tile < (M / 16) * nt; tile += ngw) {
        const int r0 = (tile / nt) * 16, c0 = (tile % nt) * 16;
        f32x4 acc = {0.f, 0.f, 0.f, 0.f};
        const bf16_t* ap = A + (size_t)(r0 + fr) * K + fq * 8; const bf16_t* bp = Bt + (size_t)(c0 + fr) * K + fq * 8;
        for (int k = 0; k < K; k += 32) { const bf16x8 a8 = *(const bf16x8*)(ap + k), b8 = *(const bf16x8*)(bp + k); acc = __builtin_amdgcn_mfma_f32_16x16x32_bf16(a8, b8, acc, 0, 0, 0); }
#pragma unroll
        for (int j = 0; j < 4; ++j) epi(r0 + fq * 4 + j, c0 + fr, acc[j]);
    }
}
#ifndef DIAG_SIMPLE
#define DIAG_SIMPLE 0
#endif
#ifndef PHMASK
#define PHMASK 0xffff
#endif
DI void gsync_own(unsigned* ctr, unsigned& epoch, unsigned G) {
    asm volatile("s_waitcnt vmcnt(0) lgkmcnt(0)" ::: "memory");
    __syncthreads();
    epoch += G;
    if (threadIdx.x == 0) {
        __builtin_amdgcn_fence(__ATOMIC_RELEASE, "agent");
        asm volatile("s_waitcnt vmcnt(0)" ::: "memory");
        __hip_atomic_fetch_add(ctr, 1u, __ATOMIC_RELAXED, __HIP_MEMORY_SCOPE_AGENT);
        while (__hip_atomic_load(ctr, __ATOMIC_RELAXED, __HIP_MEMORY_SCOPE_AGENT) < epoch) __builtin_amdgcn_s_sleep(1);
        __builtin_amdgcn_fence(__ATOMIC_ACQUIRE, "agent");
        asm volatile("s_waitcnt vmcnt(0)" ::: "memory");
    }
    __syncthreads();
}
#ifndef OWN_BARRIER
#define OWN_BARRIER 1
#endif
#if OWN_BARRIER
#define GSYNC() gsync_own((unsigned*)a.ws, epoch, (unsigned)G)
#else
#define GSYNC() grid.sync()
#endif
__global__ void __launch_bounds__(512) mk_fwd(Args a) {
    extern __shared__ __attribute__((aligned(16))) unsigned char shm[];
    LAS unsigned char* lds = (LAS unsigned char*)shm;
    cg::grid_group grid = cg::this_grid();
    const int tid = threadIdx.x, wave = tid >> 6, lane = tid & 63;
    const int G = (int)gridDim.x, gw = blockIdx.x * 8 + wave, ngw = G * 8;
    const size_t gt = (size_t)blockIdx.x * 512 + tid, ngt = (size_t)G * 512;
    bf16_t* H = (bf16_t*)(a.ws + WS_H); bf16_t* HID = (bf16_t*)(a.ws + WS_P); bf16_t* Pm = (bf16_t*)(a.ws + WS_P); bf16_t* Gt = (bf16_t*)(a.ws + WS_P);
    bf16_t* YRW = (bf16_t*)(a.ws + WS_YRW); bf16_t* YML = (bf16_t*)(a.ws + WS_YML); bf16_t* MRG = H;
    float* xinm = (float*)(a.ws + WS_XINM); float* xmeta = (float*)(a.ws + WS_XMETA); float* IFp = (float*)(a.ws + WS_IF);
    float* X = a.out;
    unsigned epoch = 0;
    grid.sync();
    if (PHMASK & 1) {
        for (size_t i = gt; i < 256 * 2048; i += ngt) xinm[i] = (i < 16 * 2048) ? a.in[I_META][i] : 0.f;
        bf16_t* w2T = (bf16_t*)(a.ws + WS_W2T); bf16_t* a2T = (bf16_t*)(a.ws + WS_A2T); bf16_t* g2T = (bf16_t*)(a.ws + WS_G2T);
        for (size_t i = gt; i < 1024 * 64; i += ngt) { const int n = (int)(i >> 6), k = (int)(i & 63);
            w2T[i] = (bf16_t)(pk2(a.in[I_W2][(size_t)k * 1024 + n], 0.f) & 0xffffu); a2T[i] = (bf16_t)(pk2(a.in[I_A2][(size_t)k * 1024 + n], 0.f) & 0xffffu); }
        for (size_t i = gt; i < 1024 * 160; i += ngt) { const int n = (int)(i / 160), k = (int)(i % 160); g2T[i] = (bf16_t)(pk2(a.in[I_G2][(size_t)k * 1024 + n], 0.f) & 0xffffu); }
        conv_ffn(a, lds, 0, gw, ngw, wave, lane);
        conv_rest(a, lds, gw, ngw, wave, lane);
        for (int r = gw; r < MA_REAL; r += ngw) {
            const float* xr = r < NPR ? a.in[I_XP] + (size_t)r * D : (r < NREAL ? a.in[I_XS] + (size_t)(r - NPR) * D : a.in[I_META] + (size_t)(r - NREAL) * D);
            rms_row_bf16(xr, a.in[I_F1N], H + (size_t)r * D, lane);
        }
    }
    GSYNC();
    if (PHMASK & 2) { EpiGU E; E.O = HID; run_gemm(lds, H, (const bf16_t*)(a.ws + WS_WGU), MA, 11008, 2048, E); }
    GSYNC();
#if DIAG_SIMPLE & 1
    simple_gemm(HID, (const bf16_t*)(a.ws + WS_WD), MA_REAL, 2048, FF, gw, ngw, lane, [&](int r, int c, float v) {
        const float* ip = r < NPR ? a.in[I_XP] + (size_t)r * D : (r < NREAL ? a.in[I_XS] + (size_t)(r - NPR) * D : xinm + (size_t)(r - NREAL) * D);
        float* op = r < NREAL ? X + (size_t)r * D : xmeta + (size_t)(r - NREAL) * D;
        op[c] = ip[c] + 0.5f * v; });
#else
    if (PHMASK & 4) { EpiDown E; E.in0 = a.in[I_XP]; E.in1 = a.in[I_XS]; E.in2 = xinm; E.o0 = X; E.o2 = xmeta; run_gemm(lds, HID, (const bf16_t*)(a.ws + WS_WD), MA, 2048, FF, E); }
#endif
    GSYNC();
    if (PHMASK & 8) {
        for (int r = gw; r < MA_REAL; r += ngw) rms_row_bf16(r < NREAL ? X + (size_t)r * D : xmeta + (size_t)(r - NREAL) * D, a.in[I_MIXN], H + (size_t)r * D, lane);
        conv_ffn(a, lds, 1, gw, ngw, wave, lane);
    }
    GSYNC();
    if (PHMASK & 16) { EpiProj E; E.O = Pm; E.IFp = IFp; run_gemm(lds, H, (const bf16_t*)(a.ws + WS_WIN), MA, PLD, 2048, E); }
    GSYNC();
    if (PHMASK & 32) for (int task = blockIdx.x; task < 1280; task += G) {
#if !defined(NO_RW)
        if (task < 128) rwkv_task(a, lds, 0, task >> 4, task & 15);
        else if (task >= 256 && task < 768) { const int r = task - 256; rwkv_task(a, lds, 1, r >> 4, r & 15); }
#endif
#if !defined(NO_ML)
        if (task >= 128 && task < 256) { const int r = task - 128; mlstm_task(a, lds, 0, r >> 4, (r >> 2) & 3, r & 3); }
        else if (task >= 768) { const int r = task - 768; mlstm_task(a, lds, 1, r >> 4, (r >> 2) & 3, r & 3); }
#endif
    }
    GSYNC();
    if (PHMASK & 64) for (int it = gw; it < MC * 4; it += ngw) {
        const int row = it >> 2, hd = it & 3;
        bf16_t* hp = YML + (size_t)row * 1024 + hd * 256 + lane * 4;
        const u32x2 hv = *(const u32x2*)hp; const u32x2 ov = *(const u32x2*)(Pm + (size_t)row * PLD + P_O + hd * 256 + lane * 4);
        const float h0 = bf_lo(hv.x), h1 = bf_hi(hv.x), h2 = bf_lo(hv.y), h3 = bf_hi(hv.y);
        const float mean = wave_sum((h0 + h1) + (h2 + h3)) * (1.f / 256.f);
        const float d0 = h0 - mean, d1 = h1 - mean, d2 = h2 - mean, d3 = h3 - mean;
        const float var = wave_sum((d0 * d0 + d1 * d1) + (d2 * d2 + d3 * d3)) * (1.f / 256.f);
        const float rs = rsqrtf(var + 1e-5f);
        const f32x4 nw = *(const f32x4*)(a.in[I_MNW] + hd * 256 + lane * 4);
        u32x2 w; w.x = pk2(d0 * rs * nw[0] * sigm(bf_lo(ov.x)), d1 * rs * nw[1] * sigm(bf_hi(ov.x))); w.y = pk2(d2 * rs * nw[2] * sigm(bf_lo(ov.y)), d3 * rs * nw[3] * sigm(bf_hi(ov.y)));
        *(u32x2*)hp = w;
    }
    GSYNC();
    if (PHMASK & 128) { EpiGate E; E.O = Gt; run_gemm(lds, H, (const bf16_t*)(a.ws + WS_WGATE), MC, 4096, 2048, E); }
    GSYNC();
    if (PHMASK & 256) { EpiBr<true> E; E.G = Gt; E.O = MRG; E.goff = 0; run_gemm(lds, YRW, (const bf16_t*)(a.ws + WS_WBRRW), MC, 2048, 1024, E); }
    if (PHMASK & 256) { EpiBr<false> E; E.G = Gt; E.O = MRG; E.goff = 2048; run_gemm(lds, YML, (const bf16_t*)(a.ws + WS_WBRML), MC, 2048, 1024, E); }
    GSYNC();
#if DIAG_SIMPLE & 2
    simple_gemm(MRG, (const bf16_t*)(a.ws + WS_WOUT), MC, 2048, 2048, gw, ngw, lane, [&](int r, int c, float v) { X[(size_t)r * D + c] += v; });
#else
    if (PHMASK & 512) { EpiOut E; E.X = X; run_gemm(lds, MRG, (const bf16_t*)(a.ws + WS_WOUT), MC, 2048, 2048, E); }
#endif
    GSYNC();
    if (PHMASK & 1024) for (int r = gw; r < MC; r += ngw) rms_row_bf16(X + (size_t)r * D, a.in[I_F2N], H + (size_t)r * D, lane);
    GSYNC();
    if (PHMASK & 2048) { EpiGU E; E.O = HID; run_gemm(lds, H, (const bf16_t*)(a.ws + WS_WGU), MC, 11008, 2048, E); }
    GSYNC();
#if DIAG_SIMPLE & 4
    simple_gemm(HID, (const bf16_t*)(a.ws + WS_WD), MC, 2048, FF, gw, ngw, lane, [&](int r, int c, float v) { X[(size_t)r * D + c] += 0.5f * v; });
#else
    if (PHMASK & 4096) { EpiDown E; E.in0 = X; E.in1 = X + (size_t)128 * 256 * D; E.in2 = xinm; E.o0 = X; E.o2 = xmeta; run_gemm(lds, HID, (const bf16_t*)(a.ws + WS_WD), MC, 2048, FF, E); }
#endif
    GSYNC();
    if (PHMASK & 8192) for (int r = gw; r < MC; r += ngw) rms_row_f32(X + (size_t)r * D, a.in[I_FN], lane, r >= NPR ? DBG_SYS : 1.f);
}

extern "C" void kernel_launch(void* const* d_in, const int* in_sizes, int n_in, void* d_out, int out_size, void* d_ws, size_t ws_size, hipStream_t stream) {
    static int grid = 0;
    if (grid == 0) {
        if (n_in != N_IN || (size_t)out_size != O_END || ws_size < WS_END) { fprintf(stderr, "kernel_launch: unexpected shapes: n_in %d out %d ws %zu (need %zu)\n", n_in, out_size, ws_size, (size_t)WS_END); grid = -1; return; }
        int dev = 0, cus = 0, per_cu = 0;
        hipGetDevice(&dev);
        hipDeviceGetAttribute(&cus, hipDeviceAttributeMultiprocessorCount, dev);
        if (hipFuncSetAttribute((const void*)mk_fwd, hipFuncAttributeMaxDynamicSharedMemorySize, LDS_BYTES) != hipSuccess) { fprintf(stderr, "kernel_launch: hipFuncSetAttribute failed\n"); grid = -1; return; }
        if (hipOccupancyMaxActiveBlocksPerMultiprocessor(&per_cu, (const void*)mk_fwd, 512, LDS_BYTES) != hipSuccess || per_cu < 1) { fprintf(stderr, "kernel_launch: occupancy query says %d\n", per_cu); per_cu = 1; }
        (void)hipGetLastError();
        grid = cus * per_cu;
    }
    if (grid < 0) return;
    if (hipMemsetAsync(d_ws, 0, 256, stream) != hipSuccess) { fprintf(stderr, "kernel_launch: memset failed\n"); return; }
    Args a{};
    for (int i = 0; i < N_IN; ++i) a.in[i] = (const float*)d_in[i];
    a.out = (float*)d_out; a.ws = (unsigned char*)d_ws;
    void* args[] = {&a};
    hipError_t e = hipLaunchCooperativeKernel((const void*)mk_fwd, dim3(grid), dim3(512), args, LDS_BYTES, stream);
    if (e != hipSuccess) fprintf(stderr, "cooperative launch failed: %s (grid %d)\n", hipGetErrorString(e), grid);
}
```

```cpp
#include <hip/hip_runtime.h>
#include <hip/hip_cooperative_groups.h>
#include <cstdio>
#include <cstdint>
namespace cg = cooperative_groups;
#define DI __device__ __forceinline__
#define LAS __attribute__((address_space(3)))
namespace pg8 {
#define PG8_LAS __attribute__((address_space(3)))
typedef unsigned short bf16_t;
typedef short bf16x8 __attribute__((ext_vector_type(8)));
typedef float f32x4 __attribute__((ext_vector_type(4)));
typedef unsigned u32x4 __attribute__((ext_vector_type(4)));
constexpr int BM = 256, BK = 64, HALF = 128, HTB = HALF * BK * 2  , STAGE_BYTES = 8 * HTB, NXCD = 8, WGM = 8;

__host__ __device__ __forceinline__ int lds_byte(int r, int c) { const int st = (r >> 4) * 2 + (c >> 5), rr = r & 15, cc = c & 31, ob = rr * 64 + cc * 2; return st * 1024 + (ob ^ (((ob >> 9) & 1) << 5)); }
__host__ __device__ __forceinline__ void stage_rc(int b, int& R, int& C) { const int st = b / 1024, sb = b % 1024, swz = sb ^ (((sb >> 9) & 1) << 5); R = (st >> 1) * 16 + swz / 64; C = (st & 1) * 32 + (swz % 64) / 2; }
__host__ __device__ __forceinline__ int perm32(int rho) { const int n = rho >> 4, i = rho & 15; return 8 * (i >> 2) + 4 * n + (i & 3); }

struct Unit { int pm, pn; };
struct Gemm { const bf16_t* A; const bf16_t* Bt; int M, N, K; };

struct StaticOrder {
    int nM, nN, nwg, G, c;
    __host__ __device__ void init(int M, int N, int G_, int c_) { nM = M / BM; nN = N / BM; nwg = nM * nN; G = G_; c = c_; }
    __host__ __device__ bool next(int i, Unit& u) const {
        const long L = (long)i * G + c; if (L >= nwg) return false;
        int wgid = (int)L; { const int q = nwg / NXCD, r = nwg % NXCD, xcd = wgid % NXCD, off = wgid / NXCD; wgid = (xcd < r ? xcd * (q + 1) : r * (q + 1) + (xcd - r) * q) + off; }
        const int nig = WGM * nN, gid = wgid / nig, fm = gid * WGM, gsz = (nM - fm) < WGM ? (nM - fm) : WGM;
        u.pm = fm + ((wgid % nig) % gsz); u.pn = (wgid % nig) / gsz; return true;
    }
    __device__ __forceinline__ void a_ready(const Unit&) const {}
    __device__ __forceinline__ void done(const Unit&) const {}
};
__device__ __forceinline__ unsigned cvt_pk_bf16(float lo, float hi) { unsigned r; asm volatile("v_cvt_pk_bf16_f32 %0, %1, %2" : "=v"(r) : "v"(lo), "v"(hi)); return r; }
template <class Epi, class Sched, bool STAMP = false>
__device__ __forceinline__ void gemm_phase(PG8_LAS unsigned char* lds, const Gemm g, const Sched& S, const Epi& E, unsigned long long* stamps) {
    int tid_ = threadIdx.x; asm volatile("" : "+v"(tid_));
    const int tid = tid_, wid = __builtin_amdgcn_readfirstlane(tid >> 6), lane = tid & 63, wr = wid >> 2, wc = wid & 3, fr = lane & 15, fq = lane >> 4;
    const int K = g.K, nt = K / BK;
    int ts_lo = 0, ts_hi = 0, nts = 0; const unsigned long long rt_entry = STAMP ? (unsigned long long)wall_clock64() : 0ull;
#define PG8_STAMP() do { if (STAMP && wid == 0 && nts < 64) { const unsigned long long _c = (unsigned long long)clock64(); \
        ts_lo = (lane == nts) ? (int)(unsigned)_c : ts_lo; ts_hi = (lane == nts) ? (int)(unsigned)(_c >> 32) : ts_hi; ++nts; } } while (0)
    PG8_STAMP();
    unsigned voffA[2], voffB[2];
#pragma unroll
    for (int i = 0; i < 2; ++i) { int R, C; stage_rc(tid * 16 + i * 8192, R, C); const int Rb = Epi::PERM ? ((R & ~31) + perm32(R & 31)) : R;
        voffA[i] = (unsigned)(R * K + C) * 2u; voffB[i] = (unsigned)(Rb * K + C) * 2u; }
    const size_t kstep = (size_t)(BK * 2);
    const size_t hstep = (size_t)HALF * K * 2;
    const size_t tstep = 2 * hstep;
    const unsigned ldsw = (unsigned)wid * 1024u;
    const int aoff = lds_byte(wr * 64 + fr, fq * 8), boff = lds_byte(wc * 32 + fr, fq * 8);
#define PG8_SA(b, h) (((b) * 2 + (h)) * HTB)
#define PG8_SB(b, h) ((4 + (b) * 2 + (h)) * HTB)
#define PG8_STAGE(bufoff, gbase, voff) do { _Pragma("unroll") for (int _i = 0; _i < 2; ++_i) \
        __builtin_amdgcn_global_load_lds((const unsigned*)((const char*)(gbase) + (voff)[_i]), (PG8_LAS unsigned*)(lds + (bufoff) + ldsw + _i * 8192), 16, 0, 0); } while (0)
#define PG8_LDA(dst, b, h) do { _Pragma("unroll") for (int m = 0; m < 4; ++m) _Pragma("unroll") for (int k = 0; k < 2; ++k) dst[m][k] = *(const PG8_LAS bf16x8*)(lds + PG8_SA(b, h) + aoff + m * 2048 + k * 1024); } while (0)
#define PG8_LDB(dst, b, h) do { _Pragma("unroll") for (int n = 0; n < 2; ++n) _Pragma("unroll") for (int k = 0; k < 2; ++k) dst[n][k] = *(const PG8_LAS bf16x8*)(lds + PG8_SB(b, h) + boff + n * 2048 + k * 1024); } while (0)
#define PG8_MMA(ai, bj, At, Bt) do { __builtin_amdgcn_s_setprio(1); _Pragma("unroll") for (int m = 0; m < 4; ++m) _Pragma("unroll") for (int n = 0; n < 2; ++n) _Pragma("unroll") for (int k = 0; k < 2; ++k) \
        acc[ai][bj][m][n] = __builtin_amdgcn_mfma_f32_16x16x32_bf16(Bt[n][k], At[m][k], acc[ai][bj][m][n], 0, 0, 0); __builtin_amdgcn_s_setprio(0); } while (0)
#define PG8_WAIT_V(n) asm volatile("s_waitcnt vmcnt(" #n ")" ::: "memory")
#define PG8_WAIT_L(n) asm volatile("s_waitcnt lgkmcnt(" #n ")" ::: "memory")
#define PG8_BAR __builtin_amdgcn_s_barrier()
#define PG8_SCHED __builtin_amdgcn_sched_barrier(0)
    Unit cur, nxt; int ui = 0;
    if (!S.next(0, cur)) return;
    f32x4 acc[2][2][4][2];
#pragma unroll
    for (int a = 0; a < 2; ++a)
#pragma unroll
        for (int b = 0; b < 2; ++b)
#pragma unroll
            for (int m = 0; m < 4; ++m)
#pragma unroll
                for (int n = 0; n < 2; ++n) acc[a][b][m][n] = (f32x4){0.f, 0.f, 0.f, 0.f};
    bf16x8 At[4][2], B0[2][2], B1[2][2];
    const char* cA = (const char*)g.A + (size_t)cur.pm * tstep; const char* cB = (const char*)g.Bt + (size_t)cur.pn * tstep;
    S.a_ready(cur);
    PG8_STAGE(PG8_SB(0, 0), cB, voffB); PG8_STAGE(PG8_SA(0, 0), cA, voffA); PG8_STAGE(PG8_SB(0, 1), cB + hstep, voffB); PG8_STAGE(PG8_SA(0, 1), cA + hstep, voffA);
    if (wr == 1) PG8_BAR;
    PG8_WAIT_V(4); PG8_BAR;
    PG8_STAGE(PG8_SB(1, 0), cB + kstep, voffB); PG8_STAGE(PG8_SA(1, 0), cA + kstep, voffA); PG8_STAGE(PG8_SB(1, 1), cB + hstep + kstep, voffB);
    PG8_WAIT_V(6); PG8_BAR;
    PG8_STAMP();
    for (;;) {
        const bool has_next = S.next(ui + 1, nxt);
        const char* nA = has_next ? (const char*)g.A + (size_t)nxt.pm * tstep : cA; const char* nB = has_next ? (const char*)g.Bt + (size_t)nxt.pn * tstep : cB;
        for (int t = 0; t < nt; t += 2) {
            const bool last = (t == nt - 2);
            const char* a1 = cA + (size_t)(t + 1) * kstep;
            const char* a2 = last ? nA : cA + (size_t)(t + 2) * kstep; const char* b2 = last ? nB : cB + (size_t)(t + 2) * kstep;
            const char* a3 = a2 + kstep; const char* b3 = b2 + kstep;
            if (last && has_next) S.a_ready(nxt);
            PG8_LDB(B0, 0, 0); PG8_SCHED; PG8_LDA(At, 0, 0); PG8_STAGE(PG8_SA(1, 1), a1 + hstep, voffA);
            PG8_WAIT_L(8); PG8_BAR; PG8_WAIT_L(0); PG8_MMA(0, 0, At, B0); PG8_BAR; PG8_SCHED;
            PG8_LDB(B1, 0, 1); PG8_STAGE(PG8_SB(0, 0), b2, voffB);
            PG8_BAR; PG8_WAIT_L(0); PG8_MMA(0, 1, At, B1); PG8_BAR;
            PG8_LDA(At, 0, 1); PG8_STAGE(PG8_SA(0, 0), a2, voffA);
            PG8_BAR; PG8_WAIT_L(0); PG8_MMA(1, 0, At, B0); PG8_BAR; PG8_SCHED;
            PG8_STAGE(PG8_SB(0, 1), b2 + hstep, voffB);
            PG8_WAIT_V(6); PG8_BAR; PG8_MMA(1, 1, At, B1); PG8_BAR;
            PG8_LDB(B0, 1, 0); PG8_SCHED; PG8_LDA(At, 1, 0); PG8_STAGE(PG8_SA(0, 1), a2 + hstep, voffA);
            PG8_WAIT_L(8); PG8_BAR; PG8_WAIT_L(0); PG8_MMA(0, 0, At, B0); PG8_BAR; PG8_SCHED;
            PG8_LDB(B1, 1, 1); PG8_STAGE(PG8_SB(1, 0), b3, voffB);
            PG8_BAR; PG8_WAIT_L(0); PG8_MMA(0, 1, At, B1); PG8_BAR;
            PG8_LDA(At, 1, 1); PG8_STAGE(PG8_SA(1, 0), a3, voffA);
            PG8_BAR; PG8_WAIT_L(0); PG8_MMA(1, 0, At, B0); PG8_BAR; PG8_SCHED;
            PG8_STAGE(PG8_SB(1, 1), b3 + hstep, voffB);
            PG8_WAIT_V(6); PG8_BAR; PG8_MMA(1, 1, At, B1); PG8_BAR;
        }
        PG8_STAMP();
        if constexpr (!Epi::AFTER_DRAIN) { E(acc, cur, wr, wc, fr, fq); S.done(cur); }
        PG8_STAMP();
        if (!has_next) break;
#pragma unroll
        for (int a = 0; a < 2; ++a)
#pragma unroll
            for (int b = 0; b < 2; ++b)
#pragma unroll
                for (int m = 0; m < 4; ++m)
#pragma unroll
                    for (int n = 0; n < 2; ++n) acc[a][b][m][n] = (f32x4){0.f, 0.f, 0.f, 0.f};
        cur = nxt; cA = nA; cB = nB; ++ui;
    }
    PG8_WAIT_V(0);
    if (wr == 0) PG8_BAR;
    PG8_BAR;
    if constexpr (Epi::AFTER_DRAIN) { E.fused(acc, cur, wr, wc, fr, fq, lds, wid, lane); S.done(cur); }
    PG8_STAMP();
    if (STAMP && wid == 0) { stamps[lane] = lane < nts ? (((unsigned long long)(unsigned)ts_hi << 32) | (unsigned)ts_lo) : 0ull;
        if (lane == 62) stamps[62] = rt_entry; if (lane == 63) stamps[63] = (unsigned long long)wall_clock64(); }
#undef PG8_STAMP
#undef PG8_SA
#undef PG8_SB
#undef PG8_STAGE
#undef PG8_LDA
#undef PG8_LDB
#undef PG8_MMA
#undef PG8_WAIT_V
#undef PG8_WAIT_L
#undef PG8_BAR
#undef PG8_SCHED
}
}
using namespace pg8;
#ifndef DBG_SYS
#define DBG_SYS 1.0f
#endif
#ifndef DBG_KRW
#define DBG_KRW 1.0f
#endif
#ifndef DBG_KML
#define DBG_KML 1.0f
#endif
#ifndef DBG_SY
#define DBG_SY 1.0f
#endif
#ifndef DBG_SR
#define DBG_SR 1.0f
#endif
#ifndef DBG_SM
#define DBG_SM 1.0f
#endif
typedef unsigned u32x2 __attribute__((ext_vector_type(2)));

constexpr int D = 2048, FF = 5504;
constexpr int NPR = 32768, NREAL = 33280, MA = 33536, MC = 33280, MA_REAL = 33296;
constexpr int PLD = 7680, P_IF = 3360, P_QK = 3584, P_V = 5632, P_O = 6656;
enum { I_XP = 0, I_XS, I_SSHIFT, I_SWKV, I_SCONV, I_SC, I_SN, I_SM, I_META, I_F1N, I_F1G, I_F1U, I_F1D, I_MIXN, I_WIN, I_MU, I_W0, I_W2, I_A0, I_A2, I_G2, I_KK, I_KA, I_RK,
       I_LNW, I_LNB, I_CW, I_CB, I_IB, I_FB, I_MNW, I_BRRW, I_BRML, I_WOUT, I_F2N, I_F2G, I_F2U, I_F2D, I_FN, N_IN };
constexpr size_t O_YP = 0, O_YS = 67108864, O_PSHIFT = 68157440, O_PWKV = O_PSHIFT + 26880, O_PCONV = O_PWKV + 524288, O_PC = O_PCONV + 49152, O_PN = O_PC + 2097152,
                 O_PM = O_PN + 8192, O_SSHIFT = O_PM + 32, O_SWKV = O_SSHIFT + 107520, O_SCONV = O_SWKV + 2097152, O_SC = O_SCONV + 196608, O_SN = O_SC + 8388608,
                 O_SM = O_SN + 32768, O_END = O_SM + 128;
constexpr size_t al256(size_t x) { return (x + 255) & ~size_t(255); }
constexpr size_t WS_XINM = 4096;
constexpr size_t WS_XMETA = WS_XINM + 256 * 2048 * 4;
constexpr size_t WS_IF = WS_XMETA + 256 * 2048 * 4;
constexpr size_t WS_WGU = al256(WS_IF + (size_t)MA * 8 * 4);
constexpr size_t WS_WD = WS_WGU + (size_t)11008 * 2048 * 2;
constexpr size_t WS_WIN = WS_WD + (size_t)2048 * 5504 * 2;
constexpr size_t WS_WGATE = WS_WIN + (size_t)7680 * 2048 * 2;
constexpr size_t WS_WBRRW = WS_WGATE + (size_t)4096 * 2048 * 2;
constexpr size_t WS_WBRML = WS_WBRRW + (size_t)2048 * 1024 * 2;
constexpr size_t WS_WOUT = WS_WBRML + (size_t)2048 * 1024 * 2;
constexpr size_t WS_W2T = WS_WOUT + (size_t)2048 * 2048 * 2;
constexpr size_t WS_A2T = WS_W2T + 1024 * 64 * 2;
constexpr size_t WS_G2T = WS_A2T + 1024 * 64 * 2;
constexpr size_t WS_H = al256(WS_G2T + 1024 * 160 * 2);
constexpr size_t WS_YRW = WS_H + (size_t)MA * 2048 * 2;
constexpr size_t WS_YML = WS_YRW + (size_t)MC * 1024 * 2;
constexpr size_t WS_P = WS_YML + (size_t)MC * 1024 * 2;
constexpr int KS = 1408, NSL = 4, TAILR = 768;
constexpr size_t WS_AS = WS_P + (size_t)MA * PLD * 2;
constexpr size_t WS_BS = WS_AS + (size_t)NSL * TAILR * KS * 2;
constexpr size_t WS_PART = WS_BS + (size_t)NSL * 2048 * KS * 2;
constexpr size_t WS_END = WS_PART + (size_t)NSL * TAILR * 2048 * 4;
constexpr int LDS_BYTES = 160 * 1024;

struct Args { const float* in[N_IN]; float* out; unsigned char* ws; };

typedef __bf16 bf16n2 __attribute__((ext_vector_type(2)));
typedef float f32n2 __attribute__((ext_vector_type(2)));
DI unsigned pk2(float lo, float hi) { const f32n2 v = {lo, hi}; return __builtin_bit_cast(unsigned, __builtin_convertvector(v, bf16n2)); }
DI float bf_lo(unsigned u) { return __uint_as_float(u << 16); }
DI float bf_hi(unsigned u) { return __uint_as_float(u & 0xffff0000u); }
DI float sigm(float x) { return __builtin_amdgcn_rcpf(1.f + __expf(-x)); }
DI float wave_sum(float v) {
#pragma unroll
    for (int o = 1; o < 64; o <<= 1) v += __shfl_xor(v, o);
    return v;
}
#define LDS_WAIT() asm volatile("s_waitcnt lgkmcnt(0)" ::: "memory")
template <int CTRL> DI float dppf(float s) { return __builtin_bit_cast(float, __builtin_amdgcn_update_dpp(0, __builtin_bit_cast(int, s), CTRL, 0xF, 0xF, true)); }
DI float sum8(float s) { s += dppf<0xB1>(s); s += dppf<0x4E>(s); s += dppf<0x141>(s); return s; }
DI float sum16(float s) { s = sum8(s); s += dppf<0x140>(s); return s; }
DI void unpack8(const u32x4 v, float (&f)[8]) { f[0] = bf_lo(v.x); f[1] = bf_hi(v.x); f[2] = bf_lo(v.y); f[3] = bf_hi(v.y); f[4] = bf_lo(v.z); f[5] = bf_hi(v.z); f[6] = bf_lo(v.w); f[7] = bf_hi(v.w); }

struct EpiGU {
    static constexpr bool PERM = true, AFTER_DRAIN = false;
    bf16_t* O; bf16_t* AS;
    DI void operator()(const f32x4 (&acc)[2][2][4][2], const Unit& u, int wr, int wc, int fr, int fq) const {
        const int row0 = u.pm * 256 + wr * 64 + fr, col0 = u.pn * 128 + wc * 32 + 8 * fq;
        const int sl = u.pn / 11, cl = (u.pn % 11) * 128 + wc * 32 + 8 * fq;
#pragma unroll
        for (int ai = 0; ai < 2; ++ai)
#pragma unroll
            for (int m = 0; m < 4; ++m) {
                const int rr = row0 + ai * 128 + m * 16;
                bf16_t* rowp = (u.pm >= 128) ? AS + ((size_t)sl * TAILR + (rr - NPR)) * KS + cl : O + (size_t)rr * FF + col0;
                float v[8];
#pragma unroll
                for (int n = 0; n < 2; ++n)
#pragma unroll
                    for (int j = 0; j < 4; ++j) { const float g = acc[ai][0][m][n][j], up = acc[ai][1][m][n][j]; v[n * 4 + j] = g * sigm(g) * up; }
                u32x4 w; w.x = pk2(v[0], v[1]); w.y = pk2(v[2], v[3]); w.z = pk2(v[4], v[5]); w.w = pk2(v[6], v[7]);
                *(u32x4*)rowp = w;
            }
    }
};
struct EpiDown {
    static constexpr bool PERM = true, AFTER_DRAIN = false;
    const float *in0, *in1, *in2; float *o0, *o2;
    DI void operator()(const f32x4 (&acc)[2][2][4][2], const Unit& u, int wr, int wc, int fr, int fq) const {
        const float* ib = u.pm < 128 ? in0 + (size_t)u.pm * 256 * D : (u.pm < 130 ? in1 + (size_t)(u.pm - 128) * 256 * D : in2);
        float* ob = u.pm < 130 ? o0 + (size_t)u.pm * 256 * D : o2;
        const int rl0 = wr * 64 + fr, col0 = u.pn * 256 + wc * 32 + 8 * fq;
#pragma unroll
        for (int ai = 0; ai < 2; ++ai)
#pragma unroll
            for (int m = 0; m < 4; ++m) {
                const size_t off = (size_t)(rl0 + ai * 128 + m * 16) * D + col0;
#pragma unroll
                for (int bj = 0; bj < 2; ++bj)
#pragma unroll
                    for (int n = 0; n < 2; ++n) { const f32x4 xi = *(const f32x4*)(ib + off + bj * 128 + n * 4); *(f32x4*)(ob + off + bj * 128 + n * 4) = xi + 0.5f * acc[ai][bj][m][n]; }
            }
    }
};
struct EpiProj {
    static constexpr bool PERM = true, AFTER_DRAIN = false;
    bf16_t* O; float* IFp;
    DI void operator()(const f32x4 (&acc)[2][2][4][2], const Unit& u, int wr, int wc, int fr, int fq) const {
        const int row0 = u.pm * 256 + wr * 64 + fr, col0 = u.pn * 256 + wc * 32 + 8 * fq;
        const bool ifl = (u.pn == 13) && (wc == 1) && (fq == 0);
#pragma unroll
        for (int ai = 0; ai < 2; ++ai)
#pragma unroll
            for (int m = 0; m < 4; ++m) {
                const int r = row0 + ai * 128 + m * 16;
                bf16_t* rowp = O + (size_t)r * PLD + col0;
#pragma unroll
                for (int bj = 0; bj < 2; ++bj) { const f32x4 v0 = acc[ai][bj][m][0], v1 = acc[ai][bj][m][1];
                    u32x4 w; w.x = pk2(v0[0], v0[1]); w.y = pk2(v0[2], v0[3]); w.z = pk2(v1[0], v1[1]); w.w = pk2(v1[2], v1[3]);
                    *(u32x4*)(rowp + bj * 128) = w; }
                if (ifl) { *(f32x4*)(IFp + (size_t)r * 8) = acc[ai][0][m][0]; *(f32x4*)(IFp + (size_t)r * 8 + 4) = acc[ai][0][m][1]; }
            }
    }
};
struct EpiGate {
    static constexpr bool PERM = true, AFTER_DRAIN = false;
    bf16_t* O;
    DI void operator()(const f32x4 (&acc)[2][2][4][2], const Unit& u, int wr, int wc, int fr, int fq) const {
        const int row0 = u.pm * 256 + wr * 64 + fr, col0 = u.pn * 256 + wc * 32 + 8 * fq;
#pragma unroll
        for (int ai = 0; ai < 2; ++ai)
#pragma unroll
            for (int m = 0; m < 4; ++m) {
                bf16_t* rowp = O + (size_t)(row0 + ai * 128 + m * 16) * PLD + col0;
#pragma unroll
                for (int bj = 0; bj < 2; ++bj) { const f32x4 v0 = acc[ai][bj][m][0], v1 = acc[ai][bj][m][1];
                    u32x4 w; w.x = pk2(sigm(v0[0]), sigm(v0[1])); w.y = pk2(sigm(v0[2]), sigm(v0[3])); w.z = pk2(sigm(v1[0]), sigm(v1[1])); w.w = pk2(sigm(v1[2]), sigm(v1[3]));
                    *(u32x4*)(rowp + bj * 128) = w; }
            }
    }
};
template <bool FIRST> struct EpiBr {
    static constexpr bool PERM = true, AFTER_DRAIN = false;
    const bf16_t* G; bf16_t* O; int goff;
    DI void operator()(const f32x4 (&acc)[2][2][4][2], const Unit& u, int wr, int wc, int fr, int fq) const {
        const int row0 = u.pm * 256 + wr * 64 + fr, col0 = u.pn * 256 + wc * 32 + 8 * fq;
#pragma unroll
        for (int ai = 0; ai < 2; ++ai)
#pragma unroll
            for (int m = 0; m < 4; ++m) {
                const int r = row0 + ai * 128 + m * 16;
#pragma unroll
                for (int bj = 0; bj < 2; ++bj) {
                    float g[8], o[8];
                    unpack8(*(const u32x4*)(G + (size_t)r * PLD + goff + col0 + bj * 128), g);
                    bf16_t* op = O + (size_t)r * D + col0 + bj * 128;
                    if (FIRST) {
#pragma unroll
                        for (int j = 0; j < 8; ++j) o[j] = 0.f;
                    } else unpack8(*(const u32x4*)op, o);
#pragma unroll
                    for (int n = 0; n < 2; ++n)
#pragma unroll
                        for (int j = 0; j < 4; ++j) o[n * 4 + j] += (FIRST ? DBG_KRW : DBG_KML) * g[n * 4 + j] * acc[ai][bj][m][n][j];
                    u32x4 w; w.x = pk2(o[0], o[1]); w.y = pk2(o[2], o[3]); w.z = pk2(o[4], o[5]); w.w = pk2(o[6], o[7]);
                    *(u32x4*)op = w;
                }
            }
    }
};
struct EpiOut {
    static constexpr bool PERM = true, AFTER_DRAIN = false;
    float* X;
    DI void operator()(const f32x4 (&acc)[2][2][4][2], const Unit& u, int wr, int wc, int fr, int fq) const {
        const int row0 = u.pm * 256 + wr * 64 + fr, col0 = u.pn * 256 + wc * 32 + 8 * fq;
#pragma unroll
        for (int ai = 0; ai < 2; ++ai)
#pragma unroll
            for (int m = 0; m < 4; ++m) {
                float* rowp = X + (size_t)(row0 + ai * 128 + m * 16) * D + col0;
#pragma unroll
                for (int bj = 0; bj < 2; ++bj)
#pragma unroll
                    for (int n = 0; n < 2; ++n) { f32x4* p = (f32x4*)(rowp + bj * 128 + n * 4); *p = *p + acc[ai][bj][m][n]; }
            }
    }
};
struct EpiPart {
    static constexpr bool PERM = true, AFTER_DRAIN = false;
    float* Pp;
    DI void operator()(const f32x4 (&acc)[2][2][4][2], const Unit& u, int wr, int wc, int fr, int fq) const {
        const int sl = u.pm / 3, pmr = u.pm % 3, pnr = u.pn & 7;
        const int row0 = pmr * 256 + wr * 64 + fr, col0 = pnr * 256 + wc * 32 + 8 * fq;
#pragma unroll
        for (int ai = 0; ai < 2; ++ai)
#pragma unroll
            for (int m = 0; m < 4; ++m) {
                float* rowp = Pp + ((size_t)sl * TAILR + row0 + ai * 128 + m * 16) * D + col0;
#pragma unroll
                for (int bj = 0; bj < 2; ++bj)
#pragma unroll
                    for (int n = 0; n < 2; ++n) *(f32x4*)(rowp + bj * 128 + n * 4) = acc[ai][bj][m][n];
            }
    }
};
struct TailOrder {
    int ntile, c;
    __device__ bool next(int i, Unit& u) const {
        if (i > 0 || c >= NSL * ntile * 8) return false;
        const int sl = c / (ntile * 8), rem = c % (ntile * 8);
        u.pm = sl * 3 + rem / 8; u.pn = sl * 8 + (rem & 7); return true;
    }
    __device__ __forceinline__ void a_ready(const Unit&) const {}
    __device__ __forceinline__ void done(const Unit&) const {}
};
DI void run_tail_gemm(LAS unsigned char* lds, const bf16_t* AS, const bf16_t* BS, float* Pp, int ntile) {
    Gemm g; g.A = AS; g.Bt = BS; g.M = NSL * TAILR; g.N = NSL * 2048; g.K = KS;
    TailOrder S; S.ntile = ntile; S.c = (int)blockIdx.x;
    EpiPart E; E.Pp = Pp;
    gemm_phase<EpiPart, TailOrder, false>(lds, g, S, E, nullptr);
}
template <class Epi> DI void run_gemm(LAS unsigned char* lds, const bf16_t* A, const bf16_t* Bt, int M, int N, int K, const Epi& E) {
    Gemm g; g.A = A; g.Bt = Bt; g.M = M; g.N = N; g.K = K;
    StaticOrder S; S.init(M, N, (int)gridDim.x, (int)blockIdx.x);
    gemm_phase<Epi, StaticOrder, false>(lds, g, S, E, nullptr);
}

DI void tr_item(const float* W, int K, int Nsrc, bf16_t* WT, int k0, int n0d, int n0s, int nvalid, LAS float* scr, int lane) {
    const int c = lane & 31;
#pragma unroll 8
    for (int i = 0; i < 32; ++i) { const int kk = 2 * i + (lane >> 5); scr[kk * 33 + c] = (c < nvalid) ? W[(size_t)(k0 + kk) * Nsrc + n0s + c] : 0.f; }
    LDS_WAIT();
    const int ch = lane & 7;
#pragma unroll
    for (int j = 0; j < 4; ++j) { const int n = (lane >> 3) + 8 * j; const LAS float* s = scr + (8 * ch) * 33 + n;
        u32x4 o; o.x = pk2(s[0 * 33], s[1 * 33]); o.y = pk2(s[2 * 33], s[3 * 33]); o.z = pk2(s[4 * 33], s[5 * 33]); o.w = pk2(s[6 * 33], s[7 * 33]);
        *(u32x4*)(WT + (size_t)(n0d + n) * K + k0 + 8 * ch) = o; }
    LDS_WAIT();
}
struct ItemIt {
    unsigned* q; int n, ngw, lane, ch, cur, lim;
    DI ItemIt(unsigned* q_, int n_, int gw, int ngw_, int lane_, int ch_) : q(q_), n(n_), ngw(ngw_), lane(lane_), ch(ch_), cur(q_ ? 0 : gw - ngw_), lim(0) {}
    DI bool next(int& it) {
        if (!q) { cur += ngw; it = cur; return cur < n; }
        if (cur >= lim) { unsigned b = 0; if (lane == 0) b = atomicAdd(q, (unsigned)ch); cur = (int)__builtin_amdgcn_readfirstlane(b); lim = cur + ch; }
        it = cur++; return it < n;
    }
};
DI void tr_item_s(const float* W, int Ktot, int Nsrc, bf16_t* WT, int ldd, int ks0, int kd0, int n0d, int n0s, LAS float* scr, int lane) {
    const int c = lane & 31;
#pragma unroll 8
    for (int i = 0; i < 32; ++i) { const int kk = 2 * i + (lane >> 5); scr[kk * 33 + c] = (ks0 + kk < Ktot) ? W[(size_t)(ks0 + kk) * Nsrc + n0s + c] : 0.f; }
    LDS_WAIT();
    const int ch = lane & 7;
#pragma unroll
    for (int j = 0; j < 4; ++j) { const int n = (lane >> 3) + 8 * j; const LAS float* sp = scr + (8 * ch) * 33 + n;
        u32x4 o; o.x = pk2(sp[0 * 33], sp[1 * 33]); o.y = pk2(sp[2 * 33], sp[3 * 33]); o.z = pk2(sp[4 * 33], sp[5 * 33]); o.w = pk2(sp[6 * 33], sp[7 * 33]);
        *(u32x4*)(WT + (size_t)(n0d + n) * ldd + kd0 + 8 * ch) = o; }
    LDS_WAIT();
}
DI void conv_slice_item(const Args& a, int which, int it, LAS float* scr, int lane) {
    const float* Wd = a.in[which ? I_F2D : I_F1D]; bf16_t* BS = (bf16_t*)(a.ws + WS_BS);
    const int sl = it / (22 * 64), r = it % (22 * 64), kb = r / 64, gi = r % 64;
    tr_item_s(Wd, FF, 2048, BS, KS, sl * KS + kb * 64, kb * 64, sl * 2048 + gi * 32, gi * 32, scr, lane);
}
DI void conv_ffn_item(const Args& a, int which, int it, LAS float* scr, int lane) {
    constexpr int IT_GU = 32 * 344;
    if (it < IT_GU) { const int kb = it / 344, gi = it % 344, n0d = gi * 32, pn = n0d >> 8, half = (n0d >> 7) & 1, idx = n0d & 127;
        tr_item(a.in[half ? (which ? I_F2U : I_F1U) : (which ? I_F2G : I_F1G)], 2048, FF, (bf16_t*)(a.ws + WS_WGU), kb * 64, n0d, pn * 128 + idx, 32, scr, lane); }
    else { const int r = it - IT_GU, kb = r / 64, gi = r % 64; tr_item(a.in[which ? I_F2D : I_F1D], FF, 2048, (bf16_t*)(a.ws + WS_WD), kb * 64, gi * 32, gi * 32, 32, scr, lane); }
}
DI void conv_ffn2_range(const Args& a, LAS unsigned char* lds, int lo, int hi, int gw, int ngw, int wave, int lane, unsigned* q) {
    LAS float* scr = (LAS float*)(lds + wave * 8704);
    int it; for (ItemIt ii(q, hi - lo, gw, ngw, lane, 4); ii.next(it); ) { const int u = lo + it; if (u < 16512) conv_ffn_item(a, 1, u, scr, lane); else conv_slice_item(a, 1, u - 16512, scr, lane); }
}
DI void conv_down_slices(const Args& a, LAS unsigned char* lds, int which, int gw, int ngw, int wave, int lane, unsigned* q = nullptr) {
    LAS float* scr = (LAS float*)(lds + wave * 8704);
    const float* Wd = a.in[which ? I_F2D : I_F1D]; bf16_t* BS = (bf16_t*)(a.ws + WS_BS);
    int it; for (ItemIt ii(q, NSL * 22 * 64, gw, ngw, lane, 4); ii.next(it); ) { const int sl = it / (22 * 64), r = it % (22 * 64), kb = r / 64, gi = r % 64;
        tr_item_s(Wd, FF, 2048, BS, KS, sl * KS + kb * 64, kb * 64, sl * 2048 + gi * 32, gi * 32, scr, lane); }
}
DI void conv_ffn(const Args& a, LAS unsigned char* lds, int which  , int gw, int ngw, int wave, int lane, unsigned* q = nullptr) {
    LAS float* scr = (LAS float*)(lds + wave * 8704);
    const float* Wg = a.in[which ? I_F2G : I_F1G]; const float* Wu = a.in[which ? I_F2U : I_F1U]; const float* Wd = a.in[which ? I_F2D : I_F1D];
    bf16_t* WGU = (bf16_t*)(a.ws + WS_WGU); bf16_t* WD = (bf16_t*)(a.ws + WS_WD);
    constexpr int IT_GU = 32 * 344, IT_D = 86 * 64;
    int it; for (ItemIt ii(q, IT_GU + IT_D, gw, ngw, lane, 4); ii.next(it); ) {
        if (it < IT_GU) { const int kb = it / 344, gi = it % 344, n0d = gi * 32, pn = n0d >> 8, half = (n0d >> 7) & 1, idx = n0d & 127;
            tr_item(half ? Wu : Wg, 2048, FF, WGU, kb * 64, n0d, pn * 128 + idx, 32, scr, lane); }
        else { const int r = it - IT_GU, kb = r / 64, gi = r % 64; tr_item(Wd, FF, 2048, WD, kb * 64, gi * 32, gi * 32, 32, scr, lane); }
    }
}
DI void conv_rest(const Args& a, LAS unsigned char* lds, int gw, int ngw, int wave, int lane, unsigned* q = nullptr) {
    LAS float* scr = (LAS float*)(lds + wave * 8704);
    constexpr int IT_IN = 32 * 240, IT_GATE = 32 * 128, IT_BR = 16 * 64, IT_OUT = 32 * 64;
    int it; for (ItemIt ii(q, IT_IN + IT_GATE + 2 * IT_BR + IT_OUT, gw, ngw, lane, 4); ii.next(it); ) {
        int r = it;
        if (r < IT_IN) { const int kb = r / 240, gi = r % 240, n0d = gi * 32; int n0s, nv;
            if (gi < 105) { n0s = n0d; nv = 32; } else if (gi == 105) { n0s = 7456; nv = 8; } else if (gi < 112) { n0s = 0; nv = 0; } else { n0s = 3360 + (n0d - 3584); nv = 32; }
            tr_item(a.in[I_WIN], 2048, 11560, (bf16_t*)(a.ws + WS_WIN), kb * 64, n0d, n0s, nv, scr, lane); continue; }
        r -= IT_IN;
        if (r < IT_GATE) { const int kb = r / 128, gi = r % 128; tr_item(a.in[I_WIN], 2048, 11560, (bf16_t*)(a.ws + WS_WGATE), kb * 64, gi * 32, 7464 + gi * 32, 32, scr, lane); continue; }
        r -= IT_GATE;
        if (r < IT_BR) { const int kb = r / 64, gi = r % 64; tr_item(a.in[I_BRRW], 1024, 2048, (bf16_t*)(a.ws + WS_WBRRW), kb * 64, gi * 32, gi * 32, 32, scr, lane); continue; }
        r -= IT_BR;
        if (r < IT_BR) { const int kb = r / 64, gi = r % 64; tr_item(a.in[I_BRML], 1024, 2048, (bf16_t*)(a.ws + WS_WBRML), kb * 64, gi * 32, gi * 32, 32, scr, lane); continue; }
        r -= IT_BR;
        { const int kb = r / 64, gi = r % 64; tr_item(a.in[I_WOUT], 2048, 2048, (bf16_t*)(a.ws + WS_WOUT), kb * 64, gi * 32, gi * 32, 32, scr, lane); }
    }
}
DI void rms_row2_bf16(const float* xa, const float* xb, const float* g, bf16_t* oa, bf16_t* ob, int lane) {
    f32x4 va[8], vb[8]; float sa = 0.f, sb = 0.f;
#pragma unroll
    for (int j = 0; j < 8; ++j) { va[j] = ((const f32x4*)xa)[lane + 64 * j]; vb[j] = ((const f32x4*)xb)[lane + 64 * j]; }
#pragma unroll
    for (int j = 0; j < 8; ++j) { sa += (va[j].x * va[j].x + va[j].y * va[j].y) + (va[j].z * va[j].z + va[j].w * va[j].w); sb += (vb[j].x * vb[j].x + vb[j].y * vb[j].y) + (vb[j].z * vb[j].z + vb[j].w * vb[j].w); }
    const float ra = rsqrtf(wave_sum(sa) * (1.f / D) + 1e-6f), rb = rsqrtf(wave_sum(sb) * (1.f / D) + 1e-6f);
#pragma unroll
    for (int j = 0; j < 8; ++j) { const f32x4 gg = ((const f32x4*)g)[lane + 64 * j];
        u32x2 o; o.x = pk2(va[j].x * ra * gg.x, va[j].y * ra * gg.y); o.y = pk2(va[j].z * ra * gg.z, va[j].w * ra * gg.w); ((u32x2*)oa)[lane + 64 * j] = o;
        u32x2 p; p.x = pk2(vb[j].x * rb * gg.x, vb[j].y * rb * gg.y); p.y = pk2(vb[j].z * rb * gg.z, vb[j].w * rb * gg.w); ((u32x2*)ob)[lane + 64 * j] = p; }
}
DI void rms_row_bf16(const float* xr, const float* g, bf16_t* orow, int lane) {
    f32x4 v[8]; float s = 0.f;
#pragma unroll
    for (int j = 0; j < 8; ++j) { v[j] = ((const f32x4*)xr)[lane + 64 * j]; s += (v[j].x * v[j].x + v[j].y * v[j].y) + (v[j].z * v[j].z + v[j].w * v[j].w); }
    const float r = rsqrtf(wave_sum(s) * (1.f / D) + 1e-6f);
#pragma unroll
    for (int j = 0; j < 8; ++j) { const f32x4 gg = ((const f32x4*)g)[lane + 64 * j]; u32x2 o; o.x = pk2(v[j].x * r * gg.x, v[j].y * r * gg.y); o.y = pk2(v[j].z * r * gg.z, v[j].w * r * gg.w);
        ((u32x2*)orow)[lane + 64 * j] = o; }
}
DI void rms_row2_f32(float* xa, float* xb, const float* g, int lane) {
    f32x4 va[8], vb[8]; float sa = 0.f, sb = 0.f;
#pragma unroll
    for (int j = 0; j < 8; ++j) { va[j] = ((const f32x4*)xa)[lane + 64 * j]; vb[j] = ((const f32x4*)xb)[lane + 64 * j]; }
#pragma unroll
    for (int j = 0; j < 8; ++j) { sa += (va[j].x * va[j].x + va[j].y * va[j].y) + (va[j].z * va[j].z + va[j].w * va[j].w); sb += (vb[j].x * vb[j].x + vb[j].y * vb[j].y) + (vb[j].z * vb[j].z + vb[j].w * vb[j].w); }
    const float ra = rsqrtf(wave_sum(sa) * (1.f / D) + 1e-6f) * DBG_SY, rb = rsqrtf(wave_sum(sb) * (1.f / D) + 1e-6f) * DBG_SY;
#pragma unroll
    for (int j = 0; j < 8; ++j) { const f32x4 gg = ((const f32x4*)g)[lane + 64 * j]; ((f32x4*)xa)[lane + 64 * j] = va[j] * ra * gg; ((f32x4*)xb)[lane + 64 * j] = vb[j] * rb * gg; }
}
DI void rms_row_f32(float* xr, const float* g, int lane, float dbg = 1.f) {
    f32x4 v[8]; float s = 0.f;
#pragma unroll
    for (int j = 0; j < 8; ++j) { v[j] = ((const f32x4*)xr)[lane + 64 * j]; s += (v[j].x * v[j].x + v[j].y * v[j].y) + (v[j].z * v[j].z + v[j].w * v[j].w); }
    const float r = rsqrtf(wave_sum(s) * (1.f / D) + 1e-6f);
#pragma unroll
    for (int j = 0; j < 8; ++j) { const f32x4 gg = ((const f32x4*)g)[lane + 64 * j]; ((f32x4*)xr)[lane + 64 * j] = v[j] * (r * DBG_SY * dbg) * gg; }
}
DI int seq_row(int kind, int b, int t) { return kind ? (NPR + b * 16 + t) : (t < 16 ? NREAL + t : b * 4096 + t - 16); }
typedef float f32p __attribute__((ext_vector_type(2)));
DI void rwkv_task(const Args& a, LAS unsigned char* lds, int kind, int b, int h) {
    int tid_ = threadIdx.x; asm volatile("" : "+v"(tid_));
    const int tid = tid_, wave = tid >> 6, lane = tid & 63, fr = lane & 15, fq = lane >> 4;
    constexpr int BUFB = 57856;
    constexpr int OW = 0, OA = 2048, OB = 4096, OK = 6144, OR = 8192, OV = 10240, OG = 12288, OBON = 14336;
    LAS float* Yall = (LAS float*)(lds + 2 * BUFB);
    LAS bf16_t* Atl = (LAS bf16_t*)(lds + 2 * BUFB + 16384);
    const bf16_t* P = (const bf16_t*)(a.ws + WS_P);
    const bf16_t* w2T = (const bf16_t*)(a.ws + WS_W2T); const bf16_t* a2T = (const bf16_t*)(a.ws + WS_A2T); const bf16_t* g2T = (const bf16_t*)(a.ws + WS_G2T);
    bf16_t* YRW = (bf16_t*)(a.ws + WS_YRW);
    const int T = kind ? 16 : 4112, NC = kind ? 1 : 129;
    const int pw = wave - 4;
    const int ep = lane & 15, ec = ep * 4, ehc = h * 64 + ec;
    const int gcol = lane < 24 ? (lane >> 3) * 1024 + h * 64 + (lane & 7) * 8 : 3072 + ((lane < 60 ? lane : 59) - 24) * 8;
    float mu8[8];
#pragma unroll
    for (int q = 0; q < 8; ++q) mu8[q] = a.in[I_MU][gcol + q];
    const f32x4 w0 = *(const f32x4*)(a.in[I_W0] + ehc), a0 = *(const f32x4*)(a.in[I_A0] + ehc), kkw = *(const f32x4*)(a.in[I_KK] + ehc), kaw = *(const f32x4*)(a.in[I_KA] + ehc),
                rk = *(const f32x4*)(a.in[I_RK] + ehc), lw = *(const f32x4*)(a.in[I_LNW] + ehc), lb = *(const f32x4*)(a.in[I_LNB] + ehc);
    u32x4 raw[9];
    auto issue = [&](int c) {
        const int t0 = c ? 16 + 32 * (c - 1) : 0, Lc = c ? 32 : 16;
        if (pw * 8 >= Lc || lane >= 60) return;
        const int tb = t0 + pw * 8;
#pragma unroll
        for (int q = 0; q < 9; ++q) { const int t = tb - 1 + q; raw[q] = (t >= 0) ? *(const u32x4*)(P + (size_t)seq_row(kind, b, t) * PLD + gcol) : (u32x4){0u, 0u, 0u, 0u}; }
    };
    auto prep = [&](int c) {
        const int t0 = c ? 16 + 32 * (c - 1) : 0, Lc = c ? 32 : 16;
        if (pw * 8 >= Lc) return;
        LAS float* Bf = (LAS float*)(lds + (c & 1) * BUFB);
        LAS bf16_t* Alw = Atl + pw * 2560; LAS bf16_t* Ala = Alw + 8 * 72; LAS bf16_t* Alg = Ala + 8 * 72;
        {
            const int tb = t0 + pw * 8;
            if (lane < 60) {
                float prev[8];
                if (tb > 0 || !kind) unpack8(raw[0], prev);
                else { const float* sp = a.in[I_SSHIFT] + (size_t)b * 3360 + gcol;
#pragma unroll
                    for (int q = 0; q < 8; ++q) prev[q] = sp[q]; }
#pragma unroll
                for (int jl = 0; jl < 8; ++jl) {
                    const int j = pw * 8 + jl;
                    float cur[8], u[8];
                    unpack8(raw[jl + 1], cur);
#pragma unroll
                    for (int q = 0; q < 8; ++q) { u[q] = cur[q] + mu8[q] * (prev[q] - cur[q]); prev[q] = cur[q]; }
                    if (lane < 24) { LAS float* dst = Bf + (lane < 8 ? OR : (lane < 16 ? OK : OV)) + j * 64 + (lane & 7) * 8;
                        *(LAS f32x4*)dst = (f32x4){u[0], u[1], u[2], u[3]}; *(LAS f32x4*)(dst + 4) = (f32x4){u[4], u[5], u[6], u[7]}; }
                    else {
                        LAS bf16_t* dst = lane < 32 ? Alw + jl * 72 + (lane - 24) * 8 : (lane < 40 ? Ala + jl * 72 + (lane - 32) * 8 : Alg + jl * 168 + (lane - 40) * 8);
                        u32x4 w; w.x = pk2(u[0], u[1]); w.y = pk2(u[2], u[3]); w.z = pk2(u[4], u[5]); w.w = pk2(u[6], u[7]);
                        *(LAS u32x4*)dst = w;
                    }
                }
            }
        }
        LDS_WAIT();
#pragma unroll
        for (int i = 0; i < 4; ++i) {
            const int idx = lane + 64 * i;
            if (idx < 224) {
                const bool isw = idx < 64; const int r2 = idx - 64;
                LAS bf16_t* p = isw ? Alw + (idx >> 3) * 72 + (idx & 7) * 8 : Alg + (r2 / 20) * 168 + (r2 % 20) * 8;
                const float al = isw ? 2.f : 1.f, be = isw ? 1.f : 0.f;
                float x[8]; unpack8(*(const LAS u32x4*)p, x);
#pragma unroll
                for (int q = 0; q < 8; ++q) x[q] = al * sigm(al * x[q]) - be;
                u32x4 w; w.x = pk2(x[0], x[1]); w.y = pk2(x[2], x[3]); w.z = pk2(x[4], x[5]); w.w = pk2(x[6], x[7]);
                *(LAS u32x4*)p = w;
            }
        }
        LDS_WAIT();
        {
            const int arow = fr & 7;
            bf16x8 Bc[9], Bn[9];
            auto ldB = [&](bf16x8 (&Bx)[9], int tc) { const int bcol = h * 64 + tc * 16 + fr;
#pragma unroll
                for (int ks = 0; ks < 2; ++ks) { Bx[ks] = *(const bf16x8*)(w2T + (size_t)bcol * 64 + ks * 32 + fq * 8); Bx[2 + ks] = *(const bf16x8*)(a2T + (size_t)bcol * 64 + ks * 32 + fq * 8); }
#pragma unroll
                for (int ks = 0; ks < 5; ++ks) Bx[4 + ks] = *(const bf16x8*)(g2T + (size_t)bcol * 160 + ks * 32 + fq * 8); };
            ldB(Bc, 0);
#pragma unroll
            for (int tc = 0; tc < 4; ++tc) {
                if (tc < 3) ldB(Bn, tc + 1);
                f32x4 zw = {0.f, 0.f, 0.f, 0.f}, za = zw, zg = zw;
#pragma unroll
                for (int ks = 0; ks < 2; ++ks) { zw = __builtin_amdgcn_mfma_f32_16x16x32_bf16(*(const LAS bf16x8*)(Alw + arow * 72 + ks * 32 + fq * 8), Bc[ks], zw, 0, 0, 0);
                    za = __builtin_amdgcn_mfma_f32_16x16x32_bf16(*(const LAS bf16x8*)(Ala + arow * 72 + ks * 32 + fq * 8), Bc[2 + ks], za, 0, 0, 0); }
#pragma unroll
                for (int ks = 0; ks < 5; ++ks) zg = __builtin_amdgcn_mfma_f32_16x16x32_bf16(*(const LAS bf16x8*)(Alg + arow * 168 + ks * 32 + fq * 8), Bc[4 + ks], zg, 0, 0, 0);
                asm volatile("" ::: "memory");
                if (fq < 2) {
#pragma unroll
                    for (int q = 0; q < 4; ++q) { const int o = (pw * 8 + fq * 4 + q) * 64 + tc * 16 + fr; Bf[OW + o] = zw[q]; Bf[OA + o] = za[q]; Bf[OG + o] = zg[q]; }
                }
#pragma unroll
                for (int q = 0; q < 9; ++q) Bc[q] = Bn[q];
            }
        }
        LDS_WAIT();
#pragma unroll
        for (int i = 0; i < 2; ++i) {
            const int j = pw * 8 + (lane >> 4) + 4 * i, o = j * 64 + ec;
            const f32x4 zw = *(LAS f32x4*)(Bf + OW + o), za = *(LAS f32x4*)(Bf + OA + o), uk = *(LAS f32x4*)(Bf + OK + o), ur = *(LAS f32x4*)(Bf + OR + o);
            f32x4 dec, av, kkv, kp; float ss = 0.f, bd = 0.f;
#pragma unroll
            for (int q = 0; q < 4; ++q) {
                const float e = sigm(zw[q] + w0[q]) * 0.60653066f;
                dec[q] = __expf(-e);
                av[q] = sigm(a0[q] + za[q]);
                kkv[q] = uk[q] * kkw[q]; ss += kkv[q] * kkv[q];
                kp[q] = uk[q] * (1.f + (av[q] - 1.f) * kaw[q]);
                bd += ur[q] * kp[q] * rk[q];
            }
            ss = sum16(ss); bd = sum16(bd);
            const float inv = 1.f / fmaxf(sqrtf(ss), 1e-12f);
            f32x4 na, nb;
#pragma unroll
            for (int q = 0; q < 4; ++q) { const float kk = kkv[q] * inv; na[q] = -kk; nb[q] = kk * av[q]; }
            *(LAS f32x4*)(Bf + OW + o) = dec; *(LAS f32x4*)(Bf + OA + o) = na; *(LAS f32x4*)(Bf + OB + o) = nb; *(LAS f32x4*)(Bf + OK + o) = kp;
            if (ep == 0) Bf[OBON + j] = bd;
        }
        LDS_WAIT();
    };
    auto outp = [&](int c) {
        const int t0 = c ? 16 + 32 * (c - 1) : 0, Lc = c ? 32 : 16;
        if (pw * 8 >= Lc) return;
        LAS float* Bf = (LAS float*)(lds + (c & 1) * BUFB); LAS float* Yv = Yall + (c & 1) * 2048;
#pragma unroll
        for (int i = 0; i < 2; ++i) {
            const int j = pw * 8 + (lane >> 4) + 4 * i, o = j * 64 + ec;
            const int row = seq_row(kind, b, t0 + j);
            const f32x4 y = *(LAS f32x4*)(Yv + o), vv = *(LAS f32x4*)(Bf + OV + o), gg = *(LAS f32x4*)(Bf + OG + o);
            const float mean = sum16((y[0] + y[1]) + (y[2] + y[3])) * (1.f / 64.f);
            const f32x4 d = y - mean;
            const float var = sum16((d[0] * d[0] + d[1] * d[1]) + (d[2] * d[2] + d[3] * d[3])) * (1.f / 64.f);
            const float rs = rsqrtf(var + 64e-5f), bo = Bf[OBON + j];
            if (row < NREAL) {
                f32x4 o4;
#pragma unroll
                for (int q = 0; q < 4; ++q) o4[q] = (d[q] * rs * lw[q] + lb[q] + bo * vv[q]) * gg[q];
                u32x2 w; w.x = pk2(o4[0], o4[1]); w.y = pk2(o4[2], o4[3]);
                *(u32x2*)(YRW + (size_t)row * 1024 + ehc) = w;
            }
        }
        LDS_WAIT();
    };
    const int rp = (tid >> 3) & 31, kq = tid & 7;
    f32p S0[4], S1[4];
    if (kind) { const float* s0 = a.in[I_SWKV] + ((size_t)(b * 16 + h) * 64 + rp) * 64 + kq * 8; const float* s1 = s0 + 32 * 64;
#pragma unroll
        for (int i = 0; i < 4; ++i) { S0[i] = (f32p){s0[2 * i], s0[2 * i + 1]}; S1[i] = (f32p){s1[2 * i], s1[2 * i + 1]}; } }
    else {
#pragma unroll
        for (int i = 0; i < 4; ++i) { S0[i] = (f32p){0.f, 0.f}; S1[i] = (f32p){0.f, 0.f}; } }
    if (wave >= 4) { issue(0); prep(0); if (NC > 1) issue(1); }
    __syncthreads();
    for (int c = 0; c < NC; ++c) {
        if (wave < 4) {
            const int Lc = c ? 32 : 16;
            const LAS float* Bf = (const LAS float*)(lds + (c & 1) * BUFB); LAS float* Yv = Yall + (c & 1) * 2048;
#pragma unroll 2
            for (int j = 0; j < Lc; ++j) {
                const int o = j * 64 + kq * 8;
                f32p w[4], aa[4], bb[4], kk[4], rr[4];
#pragma unroll
                for (int i = 0; i < 4; ++i) { w[i] = *(const LAS f32p*)(Bf + OW + o + 2 * i); aa[i] = *(const LAS f32p*)(Bf + OA + o + 2 * i); bb[i] = *(const LAS f32p*)(Bf + OB + o + 2 * i);
                    kk[i] = *(const LAS f32p*)(Bf + OK + o + 2 * i); rr[i] = *(const LAS f32p*)(Bf + OR + o + 2 * i); }
                const float v0 = Bf[OV + j * 64 + rp], v1 = Bf[OV + j * 64 + rp + 32];
                f32p p0 = S0[0] * aa[0], p1 = S1[0] * aa[0];
#pragma unroll
                for (int i = 1; i < 4; ++i) { p0 += S0[i] * aa[i]; p1 += S1[i] * aa[i]; }
                const float sa0 = sum8(p0.x + p0.y), sa1 = sum8(p1.x + p1.y);
                const f32p sa0v = {sa0, sa0}, sa1v = {sa1, sa1}, v0v = {v0, v0}, v1v = {v1, v1};
#pragma unroll
                for (int i = 0; i < 4; ++i) { S0[i] = S0[i] * w[i] + sa0v * bb[i] + v0v * kk[i]; S1[i] = S1[i] * w[i] + sa1v * bb[i] + v1v * kk[i]; }
                f32p q0 = S0[0] * rr[0], q1 = S1[0] * rr[0];
#pragma unroll
                for (int i = 1; i < 4; ++i) { q0 += S0[i] * rr[i]; q1 += S1[i] * rr[i]; }
                const float y0 = sum8(q0.x + q0.y), y1 = sum8(q1.x + q1.y);
                if (kq == 0) { Yv[j * 64 + rp] = y0; Yv[j * 64 + rp + 32] = y1; }
            }
        } else {
            if (c >= 1) outp(c - 1);
            if (c + 1 < NC) prep(c + 1);
            if (c + 2 < NC) issue(c + 2);
        }
        __syncthreads();
    }
    if (wave >= 4) outp(NC - 1);
    if (wave < 4) {
        float* so = a.out + (kind ? O_SWKV : O_PWKV) + ((size_t)(b * 16 + h) * 64 + rp) * 64 + kq * 8;
        *(f32x4*)so = (f32x4){S0[0].x, S0[0].y, S0[1].x, S0[1].y} * DBG_SR; *(f32x4*)(so + 4) = (f32x4){S0[2].x, S0[2].y, S0[3].x, S0[3].y} * DBG_SR;
        so += 32 * 64;
        *(f32x4*)so = (f32x4){S1[0].x, S1[0].y, S1[1].x, S1[1].y} * DBG_SR; *(f32x4*)(so + 4) = (f32x4){S1[2].x, S1[2].y, S1[3].x, S1[3].y} * DBG_SR;
    }
    if (h == 0) {
        float* sh = a.out + (kind ? O_SSHIFT : O_PSHIFT) + (size_t)b * 3360;
        const bf16_t* pr = P + (size_t)seq_row(kind, b, T - 1) * PLD;
        for (int c = tid; c < 3360; c += 512) sh[c] = __uint_as_float((unsigned)pr[c] << 16);
    }
    __syncthreads();
}
DI int off512(int row, int chunk) { return row * 512 + ((chunk ^ (row & 15)) << 4); }
DI int off128(int row, int chunk) { return row * 128 + ((chunk ^ ((row >> 1) & 7)) << 4); }
DI u32x4 ml_qk_row(const Args& a, const bf16_t* P, int kind, int b, int T, int tg, int chan) {
    u32x4 z = {0u, 0u, 0u, 0u};
    if (tg >= T) return z;
    if (tg < 0) {
        if (!kind) return z;
        const float* sp = a.in[I_SCONV] + ((size_t)b * 3 + (3 + tg)) * 2048 + chan;
        u32x4 w; w.x = pk2(sp[0], sp[1]); w.y = pk2(sp[2], sp[3]); w.z = pk2(sp[4], sp[5]); w.w = pk2(sp[6], sp[7]); return w;
    }
    return *(const u32x4*)(P + (size_t)seq_row(kind, b, tg) * PLD + P_QK + chan);
}
DI void mlstm_task(const Args& a, LAS unsigned char* lds, int kind, int b, int head, int vs) {
    int tid_ = threadIdx.x; asm volatile("" : "+v"(tid_));
    const int tid = tid_, wave = tid >> 6, lane = tid & 63, fr_ = lane & 15, fq_ = lane >> 4;
    LAS unsigned char* qs = lds; LAS unsigned char* ks = lds + 32768; LAS unsigned char* kT = lds + 65536; LAS unsigned char* vT = lds + 98304;
    LAS unsigned char* CbT = lds + 106496; LAS unsigned char* sP = lds + 139264;
    LAS float* nS = (LAS float*)(lds + 147456); LAS float* sc_c = nS + 256; LAS float* sc_M = sc_c + 64; LAS float* sc_win = sc_M + 64; LAS float* sc_enmq = sc_win + 64;
    LAS float* sc_wk = sc_enmq + 64; LAS float* denp = sc_wk + 64; LAS float* dinvS = denp + 128; LAS float* misc = dinvS + 64;
    const bf16_t* P = (const bf16_t*)(a.ws + WS_P); const float* IFp = (const float*)(a.ws + WS_IF); bf16_t* HM = (bf16_t*)(a.ws + WS_YML);
    const int T = kind ? 16 : 4112;
    const float ib = a.in[I_IB][head], fb = a.in[I_FB][head];
    f32x4 Cacc[2][4];
    {
        const int fr = fr_, fq = fq_;
        const float* C0 = a.in[I_SC] + (size_t)(b * 4 + head) * 65536 + vs * 64;
#pragma unroll
        for (int k2 = 0; k2 < 2; ++k2)
#pragma unroll
            for (int vt = 0; vt < 4; ++vt)
#pragma unroll
                for (int j = 0; j < 4; ++j) { const int key = (wave * 2 + k2) * 16 + fq * 4 + j, v = vt * 16 + fr; Cacc[k2][vt][j] = kind ? C0[(size_t)key * 256 + v] : 0.f; }
#pragma unroll
        for (int k2 = 0; k2 < 2; ++k2)
#pragma unroll
            for (int vt = 0; vt < 4; ++vt) { const int key0 = (wave * 2 + k2) * 16 + fq * 4, v = vt * 16 + fr; u32x2 w; w.x = pk2(Cacc[k2][vt][0], Cacc[k2][vt][1]); w.y = pk2(Cacc[k2][vt][2], Cacc[k2][vt][3]);
                *(LAS u32x2*)(CbT + off512(v, key0 >> 3) + (key0 & 7) * 2) = w; }
        if (tid < 256) nS[tid] = kind ? a.in[I_SN][(size_t)(b * 4 + head) * 256 + tid] : 0.f;
    }
    float m = kind ? a.in[I_SM][b * 4 + head] : 0.f;
    float pre_i = 0.f, pre_f = 0.f;
    if (wave == 0 && lane < 16) { const int r0 = seq_row(kind, b, lane); pre_i = IFp[(size_t)r0 * 8 + head]; pre_f = IFp[(size_t)r0 * 8 + 4 + head]; }
    __syncthreads();
    for (int t0 = 0; t0 < T;) {
        const int L = (t0 == 0) ? 16 : 64;
        if (wave == 0) {
            const int t = lane; const bool valid = t < L;
            const float iv = valid ? pre_i + ib : -INFINITY;
            const float x = valid ? pre_f + fb : 0.f;
            { const int tn = t0 + L + t; if (tn < T) { const int rn = seq_row(kind, b, tn); pre_i = IFp[(size_t)rn * 8 + head]; pre_f = IFp[(size_t)rn * 8 + 4 + head]; } }
            const float lf = valid ? (fminf(x, 0.f) - log1pf(__expf(-fabsf(x)))) : 0.f;
            float bs = lf;
#pragma unroll
            for (int o = 1; o < 64; o <<= 1) { const float y = __shfl_up(bs, o); if (lane >= o) bs += y; }
            const float c = iv - bs;
            float pm = c;
#pragma unroll
            for (int o = 1; o < 64; o <<= 1) { const float y = __shfl_up(pm, o); if (lane >= o) pm = fmaxf(pm, y); }
            const float M = fmaxf(m, pm);
            const float M63 = __shfl(M, 63), b63 = __shfl(bs, 63);
            sc_c[t] = c; sc_M[t] = M; sc_win[t] = __expf(m - M); sc_enmq[t] = __expf(-(bs + M)); sc_wk[t] = __expf(c - M63);
            if (lane == 0) { misc[0] = __expf(m - M63); misc[1] = b63 + M63; }
        }
        __syncthreads();
#ifndef NO_B
        {
            const int cgp = tid & 63, pg = wave; const bool isk = cgp >= 32; const int kc = cgp & 31;
            const int chan = (isk ? 1024 : 0) + head * 256 + kc * 8;
            const int pos = tid >> 3, c8 = tid & 7;
            u32x4 vv = {0u, 0u, 0u, 0u};
            if (pos < L) vv = *(const u32x4*)(P + (size_t)seq_row(kind, b, t0 + pos) * PLD + P_V + head * 256 + vs * 64 + c8 * 8);
            float cw[4][8], cb[8];
#pragma unroll
            for (int j = 0; j < 4; ++j)
#pragma unroll
                for (int i = 0; i < 8; ++i) cw[j][i] = a.in[I_CW][j * 2048 + chan + i];
#pragma unroll
            for (int i = 0; i < 8; ++i) cb[i] = a.in[I_CB][chan + i];
            u32x4 raw[11];
#pragma unroll
            for (int q = 0; q < 11; ++q) raw[q] = ml_qk_row(a, P, kind, b, T, t0 + pg * 8 - 3 + q, chan);
            float x0[8], x1[8], x2[8];
            unpack8(raw[0], x0); unpack8(raw[1], x1); unpack8(raw[2], x2);
#pragma unroll
            for (int p = 0; p < 8; ++p) {
                const int tt = pg * 8 + p;
                float o[8], x3[8];
                unpack8(raw[p + 3], x3);
#pragma unroll
                for (int i = 0; i < 8; ++i) { float s = cb[i] + cw[0][i] * x0[i] + cw[1][i] * x1[i] + cw[2][i] * x2[i] + cw[3][i] * x3[i]; s = s * sigm(s); if (isk) s *= 0.0625f; o[i] = (tt < L) ? s : 0.f; }
                u32x4 w; w.x = pk2(o[0], o[1]); w.y = pk2(o[2], o[3]); w.z = pk2(o[4], o[5]); w.w = pk2(o[6], o[7]);
                *(LAS u32x4*)((isk ? ks : qs) + off512(tt, kc)) = w;
                if (isk) {
                    const float wkp = sc_wk[tt];
#pragma unroll
                    for (int i = 0; i < 8; ++i) *(LAS unsigned short*)(kT + off128(kc * 8 + i, pg) + p * 2) = (unsigned short)(pk2(o[i] * wkp, 0.f) & 0xffffu);
                }
#pragma unroll
                for (int i = 0; i < 8; ++i) { x0[i] = x1[i]; x1[i] = x2[i]; x2[i] = x3[i]; }
            }
            const unsigned vw[4] = {vv.x, vv.y, vv.z, vv.w};
#pragma unroll
            for (int i = 0; i < 8; ++i) { const int v = c8 * 8 + i; const unsigned short hv = (unsigned short)((i & 1) ? (vw[i >> 1] >> 16) : (vw[i >> 1] & 0xffffu));
                *(LAS unsigned short*)(vT + off128(v, pos >> 3) + (pos & 7) * 2) = hv; }
        }
#endif
        __syncthreads();
        {
            int fr = fr_, fq = fq_; asm volatile("" : "+v"(fr), "+v"(fq));
            const int tt_ = wave >> 1; const int t = tt_ * 16 + fr; const float Mt = sc_M[t];
            float rowsum = 0.f;
#pragma unroll
            for (int si = 0; si < 2; ++si) {
                const int st = (wave & 1) * 2 + si, s0 = st * 16 + fq * 4;
                u32x2 w = {0u, 0u};
                if (st <= tt_) {
                    f32x4 acc = {0.f, 0.f, 0.f, 0.f};
#pragma unroll
                    for (int kk = 0; kk < 8; ++kk) { const int ch = kk * 4 + fq;
                        const bf16x8 A = *(const LAS bf16x8*)(ks + off512(st * 16 + fr, ch)), B = *(const LAS bf16x8*)(qs + off512(t, ch));
                        acc = __builtin_amdgcn_mfma_f32_16x16x32_bf16(A, B, acc, 0, 0, 0); }
                    const f32x4 cs = *(const LAS f32x4*)(sc_c + s0);
                    float val[4];
#pragma unroll
                    for (int j = 0; j < 4; ++j) { val[j] = (s0 + j <= t) ? acc[j] * __expf(cs[j] - Mt) : 0.f; rowsum += val[j]; }
                    w.x = pk2(val[0], val[1]); w.y = pk2(val[2], val[3]);
                }
                *(LAS u32x2*)(sP + off128(t, s0 >> 3) + (s0 & 7) * 2) = w;
            }
            rowsum += __shfl_xor(rowsum, 16); rowsum += __shfl_xor(rowsum, 32);
            if (fq == 0) denp[(wave & 1) * 64 + t] = rowsum;
        }
        __syncthreads();
        {
            int tidx = tid; asm volatile("" : "+v"(tidx));
            const int t = tidx >> 3, part = tidx & 7; float qn = 0.f;
#pragma unroll
            for (int i = 0; i < 4; ++i) { const int c4 = part * 4 + i; float q8[8]; unpack8(*(const LAS u32x4*)(qs + off512(t, c4)), q8);
                const f32x4 n0 = *(const LAS f32x4*)(nS + c4 * 8), n1 = *(const LAS f32x4*)(nS + c4 * 8 + 4);
                qn += (q8[0] * n0[0] + q8[1] * n0[1]) + (q8[2] * n0[2] + q8[3] * n0[3]) + (q8[4] * n1[0] + q8[5] * n1[1]) + (q8[6] * n1[2] + q8[7] * n1[3]); }
            qn = sum8(qn);
            const float den = sc_win[t] * qn + denp[t] + denp[64 + t];
            if (part == 0) dinvS[t] = 1.f / fmaxf(fabsf(den), sc_enmq[t]);
        }
        __syncthreads();
        {
            int fr = fr_, fq = fq_; asm volatile("" : "+v"(fr), "+v"(fq));
            const int tt_ = wave >> 1; const int t = tt_ * 16 + fr;
            f32x4 a1[2], a2[2];
#pragma unroll
            for (int vi = 0; vi < 2; ++vi) { a1[vi] = (f32x4){0.f, 0.f, 0.f, 0.f}; a2[vi] = a1[vi]; }
#pragma unroll
            for (int kk = 0; kk < 8; ++kk) { const int ch = kk * 4 + fq; const bf16x8 B = *(const LAS bf16x8*)(qs + off512(t, ch));
#pragma unroll
                for (int vi = 0; vi < 2; ++vi) { const int vt = (wave & 1) * 2 + vi; const bf16x8 A = *(const LAS bf16x8*)(CbT + off512(vt * 16 + fr, ch)); a1[vi] = __builtin_amdgcn_mfma_f32_16x16x32_bf16(A, B, a1[vi], 0, 0, 0); } }
#pragma unroll
            for (int kk = 0; kk < 2; ++kk) { const int ch = kk * 4 + fq; const bf16x8 B = *(const LAS bf16x8*)(sP + off128(t, ch));
#pragma unroll
                for (int vi = 0; vi < 2; ++vi) { const int vt = (wave & 1) * 2 + vi; const bf16x8 A = *(const LAS bf16x8*)(vT + off128(vt * 16 + fr, ch)); a2[vi] = __builtin_amdgcn_mfma_f32_16x16x32_bf16(A, B, a2[vi], 0, 0, 0); } }
            if (t < L) {
                const int row = seq_row(kind, b, t0 + t);
                if (row < NREAL) {
                    const float win = sc_win[t], di = dinvS[t];
#pragma unroll
                    for (int vi = 0; vi < 2; ++vi) { const int vt = (wave & 1) * 2 + vi; u32x2 w;
                        w.x = pk2((win * a1[vi][0] + a2[vi][0]) * di, (win * a1[vi][1] + a2[vi][1]) * di); w.y = pk2((win * a1[vi][2] + a2[vi][2]) * di, (win * a1[vi][3] + a2[vi][3]) * di);
                        *(u32x2*)(HM + (size_t)row * 1024 + head * 256 + vs * 64 + vt * 16 + fq * 4) = w; }
                }
            }
        }
        __syncthreads();
        {
            int fr = fr_, fq = fq_, tidx = tid; asm volatile("" : "+v"(fr), "+v"(fq), "+v"(tidx));
            const float ast = misc[0], mnew = misc[1];
#pragma unroll
            for (int k2 = 0; k2 < 2; ++k2)
#pragma unroll
                for (int vt = 0; vt < 4; ++vt) Cacc[k2][vt] = Cacc[k2][vt] * ast;
#pragma unroll
            for (int kk = 0; kk < 2; ++kk) { const int ch = kk * 4 + fq;
                bf16x8 Bv[4];
#pragma unroll
                for (int vt = 0; vt < 4; ++vt) Bv[vt] = *(const LAS bf16x8*)(vT + off128(vt * 16 + fr, ch));
#pragma unroll
                for (int k2 = 0; k2 < 2; ++k2) { const bf16x8 A = *(const LAS bf16x8*)(kT + off128((wave * 2 + k2) * 16 + fr, ch));
#pragma unroll
                    for (int vt = 0; vt < 4; ++vt) Cacc[k2][vt] = __builtin_amdgcn_mfma_f32_16x16x32_bf16(A, Bv[vt], Cacc[k2][vt], 0, 0, 0); } }
#pragma unroll
            for (int k2 = 0; k2 < 2; ++k2)
#pragma unroll
                for (int vt = 0; vt < 4; ++vt) { const int key0 = (wave * 2 + k2) * 16 + fq * 4, v = vt * 16 + fr; u32x2 w; w.x = pk2(Cacc[k2][vt][0], Cacc[k2][vt][1]); w.y = pk2(Cacc[k2][vt][2], Cacc[k2][vt][3]);
                    *(LAS u32x2*)(CbT + off512(v, key0 >> 3) + (key0 & 7) * 2) = w; }
            if (tidx < 256) { float s = 0.f;
#pragma unroll
                for (int c = 0; c < 8; ++c) { float k8[8]; unpack8(*(const LAS u32x4*)(kT + off128(tidx, c)), k8); s += (k8[0] + k8[1]) + (k8[2] + k8[3]) + (k8[4] + k8[5]) + (k8[6] + k8[7]); }
                nS[tidx] = ast * nS[tidx] + s; }
            m = mnew;
        }
        __syncthreads();
        t0 += L;
    }
    {
        const int fr = fr_, fq = fq_;
        float* Co = a.out + (kind ? O_SC : O_PC) + (size_t)(b * 4 + head) * 65536 + vs * 64;
#pragma unroll
        for (int k2 = 0; k2 < 2; ++k2)
#pragma unroll
            for (int vt = 0; vt < 4; ++vt)
#pragma unroll
                for (int j = 0; j < 4; ++j) { const int key = (wave * 2 + k2) * 16 + fq * 4 + j, v = vt * 16 + fr; Co[(size_t)key * 256 + v] = Cacc[k2][vt][j] * DBG_SM; }
        if (vs == 0) {
            if (tid < 256) a.out[(kind ? O_SN : O_PN) + (size_t)(b * 4 + head) * 256 + tid] = nS[tid] * DBG_SM;
            if (tid == 0) a.out[(kind ? O_SM : O_PM) + b * 4 + head] = m * DBG_SM;
            if (head == 0) {
                float* co = a.out + (kind ? O_SCONV : O_PCONV) + (size_t)b * 3 * 2048;
                for (int i = tid; i < 3 * 2048; i += 512) { const int j = i >> 11, ch = i & 2047; co[i] = __uint_as_float((unsigned)P[(size_t)seq_row(kind, b, T - 3 + j) * PLD + P_QK + ch] << 16); }
            }
        }
    }
    __syncthreads();
}
template <class F> DI void simple_gemm(const bf16_t* A, const bf16_t* Bt, int M, int N, int K, int gw, int ngw, int lane, F&& epi) {
    const int fr = lane & 15, fq = lane >> 4, nt = N / 16;
    for (int tile = gw; tile < (M / 16) * nt; tile += ngw) {
        const int r0 = (tile / nt) * 16, c0 = (tile % nt) * 16;
        f32x4 acc = {0.f, 0.f, 0.f, 0.f};
        const bf16_t* ap = A + (size_t)(r0 + fr) * K + fq * 8; const bf16_t* bp = Bt + (size_t)(c0 + fr) * K + fq * 8;
        for (int k = 0; k < K; k += 32) { const bf16x8 a8 = *(const bf16x8*)(ap + k), b8 = *(const bf16x8*)(bp + k); acc = __builtin_amdgcn_mfma_f32_16x16x32_bf16(a8, b8, acc, 0, 0, 0); }
#pragma unroll
        for (int j = 0; j < 4; ++j) epi(r0 + fq * 4 + j, c0 + fr, acc[j]);
    }
}
#ifndef DIAG_SIMPLE
#define DIAG_SIMPLE 0
#endif
#ifndef PHMASK
#define PHMASK 0xffff
#endif
DI void gsync_own(unsigned* ctl, unsigned& epoch, unsigned G) {
    asm volatile("s_waitcnt vmcnt(0) lgkmcnt(0)" ::: "memory");
    __syncthreads();
    epoch += 1;
    if (threadIdx.x == 0) {
        __builtin_amdgcn_fence(__ATOMIC_RELEASE, "agent");
        asm volatile("s_waitcnt vmcnt(0)" ::: "memory");
        const unsigned x = blockIdx.x & 7u, nper = (G + 7u - x) >> 3, ngrp = G < 8u ? G : 8u;
        const unsigned old = __hip_atomic_fetch_add(ctl + 128 + 64 * x, 1u, __ATOMIC_RELAXED, __HIP_MEMORY_SCOPE_AGENT);
        if (old + 1u == epoch * nper) __hip_atomic_fetch_add(ctl + 64, 1u, __ATOMIC_RELAXED, __HIP_MEMORY_SCOPE_AGENT);
        while (__hip_atomic_load(ctl + 64, __ATOMIC_RELAXED, __HIP_MEMORY_SCOPE_AGENT) < epoch * ngrp) __builtin_amdgcn_s_sleep(1);
        __builtin_amdgcn_fence(__ATOMIC_ACQUIRE, "agent");
        asm volatile("s_waitcnt vmcnt(0)" ::: "memory");
    }
    __syncthreads();
}
#ifndef OWN_BARRIER
#define OWN_BARRIER 1
#endif
#if OWN_BARRIER
#define GSYNC() gsync_own((unsigned*)a.ws, epoch, (unsigned)G)
#else
#define GSYNC() grid.sync()
#endif
__global__ void __launch_bounds__(512) mk_fwd(Args a) {
    extern __shared__ __attribute__((aligned(16))) unsigned char shm[];
    LAS unsigned char* lds = (LAS unsigned char*)shm;
    cg::grid_group grid = cg::this_grid();
    const int G = (int)gridDim.x, ngw = G * 8;
    const size_t ngt = (size_t)G * 512;
#ifndef FFN2_CAP
#define FFN2_CAP 7168
#endif
#define PH_IDS int tid_ph = threadIdx.x; asm volatile("" : "+v"(tid_ph)); const int wave = tid_ph >> 6, lane = tid_ph & 63, gw = blockIdx.x * 8 + wave; const size_t gt = (size_t)blockIdx.x * 512 + tid_ph; (void)gt; (void)gw; (void)lane; (void)wave;
    bf16_t* H = (bf16_t*)(a.ws + WS_H); bf16_t* HID = (bf16_t*)(a.ws + WS_P); bf16_t* Pm = (bf16_t*)(a.ws + WS_P); bf16_t* Gt = (bf16_t*)(a.ws + WS_P);
    bf16_t* YRW = (bf16_t*)(a.ws + WS_YRW); bf16_t* YML = (bf16_t*)(a.ws + WS_YML); bf16_t* MRG = H;
    float* xinm = (float*)(a.ws + WS_XINM); float* xmeta = (float*)(a.ws + WS_XMETA); float* IFp = (float*)(a.ws + WS_IF);
    float* X = a.out;
    unsigned epoch = 0;
    grid.sync();
    if (PHMASK & 1) { PH_IDS
        for (size_t i = gt; i < 256 * 2048; i += ngt) xinm[i] = (i < 16 * 2048) ? a.in[I_META][i] : 0.f;
        bf16_t* w2T = (bf16_t*)(a.ws + WS_W2T); bf16_t* a2T = (bf16_t*)(a.ws + WS_A2T); bf16_t* g2T = (bf16_t*)(a.ws + WS_G2T);
        for (size_t i = gt; i < 1024 * 64; i += ngt) { const int n = (int)(i >> 6), k = (int)(i & 63);
            w2T[i] = (bf16_t)(pk2(a.in[I_W2][(size_t)k * 1024 + n], 0.f) & 0xffffu); a2T[i] = (bf16_t)(pk2(a.in[I_A2][(size_t)k * 1024 + n], 0.f) & 0xffffu); }
        for (size_t i = gt; i < 1024 * 160; i += ngt) { const int n = (int)(i / 160), k = (int)(i % 160); g2T[i] = (bf16_t)(pk2(a.in[I_G2][(size_t)k * 1024 + n], 0.f) & 0xffffu); }
        { bf16_t* AS = (bf16_t*)(a.ws + WS_AS);
          for (size_t i = gt; i < (size_t)TAILR * 128; i += ngt) AS[((size_t)3 * TAILR + i / 128) * KS + 1280 + (i % 128)] = 0; }
        conv_ffn(a, lds, 0, gw, ngw, wave, lane);
        conv_down_slices(a, lds, 0, gw, ngw, wave, lane);
        if ((NPR % (2 * ngw)) == 0) for (int r = gw; r < NPR; r += 2 * ngw) rms_row2_bf16(a.in[I_XP] + (size_t)r * D, a.in[I_XP] + (size_t)(r + ngw) * D, a.in[I_F1N], H + (size_t)r * D, H + (size_t)(r + ngw) * D, lane);
        for (int r = ((NPR % (2 * ngw)) == 0 ? NPR : 0) + gw; r < MA_REAL; r += ngw) {
            const float* xr = r < NPR ? a.in[I_XP] + (size_t)r * D : (r < NREAL ? a.in[I_XS] + (size_t)(r - NPR) * D : a.in[I_META] + (size_t)(r - NREAL) * D);
            rms_row_bf16(xr, a.in[I_F1N], H + (size_t)r * D, lane);
        }
    }
    GSYNC();
    if (PHMASK & 2) { EpiGU E; E.O = HID; E.AS = (bf16_t*)(a.ws + WS_AS); run_gemm(lds, H, (const bf16_t*)(a.ws + WS_WGU), MA, 11008, 2048, E);
        PH_IDS conv_rest(a, lds, gw, ngw, wave, lane, (unsigned*)a.ws + 16); }
    GSYNC();
#if DIAG_SIMPLE & 1
    simple_gemm(HID, (const bf16_t*)(a.ws + WS_WD), MA_REAL, 2048, FF, gw, ngw, lane, [&](int r, int c, float v) {
        const float* ip = r < NPR ? a.in[I_XP] + (size_t)r * D : (r < NREAL ? a.in[I_XS] + (size_t)(r - NPR) * D : xinm + (size_t)(r - NREAL) * D);
        float* op = r < NREAL ? X + (size_t)r * D : xmeta + (size_t)(r - NREAL) * D;
        op[c] = ip[c] + 0.5f * v; });
#else
    if (PHMASK & 4) { EpiDown E; E.in0 = a.in[I_XP]; E.in1 = a.in[I_XS]; E.in2 = xinm; E.o0 = X; E.o2 = xmeta; run_gemm(lds, HID, (const bf16_t*)(a.ws + WS_WD), NPR, 2048, FF, E);
        run_tail_gemm(lds, (const bf16_t*)(a.ws + WS_AS), (const bf16_t*)(a.ws + WS_BS), (float*)(a.ws + WS_PART), 3); }
#endif
    GSYNC();
    if (PHMASK & 8) { PH_IDS
        if ((NPR % (2 * ngw)) == 0) for (int r = gw; r < NPR; r += 2 * ngw) rms_row2_bf16(X + (size_t)r * D, X + (size_t)(r + ngw) * D, a.in[I_MIXN], H + (size_t)r * D, H + (size_t)(r + ngw) * D, lane);
        for (int r = ((NPR % (2 * ngw)) == 0 ? NPR : 0) + gw; r < MA_REAL; r += ngw) {
            float* xr = r < NREAL ? X + (size_t)r * D : xmeta + (size_t)(r - NREAL) * D;
            if (r >= NPR) {
                const float* xi = r < NREAL ? a.in[I_XS] + (size_t)(r - NPR) * D : a.in[I_META] + (size_t)(r - NREAL) * D;
                const float* pp = (const float*)(a.ws + WS_PART) + (size_t)(r - NPR) * D;
#pragma unroll
                for (int j = 0; j < 8; ++j) { const int e = lane + 64 * j; f32x4 v = ((const f32x4*)pp)[e];
#pragma unroll
                    for (int q = 1; q < NSL; ++q) v += ((const f32x4*)(pp + (size_t)q * TAILR * D))[e];
                    ((f32x4*)xr)[e] = ((const f32x4*)xi)[e] + 0.5f * v; }
            }
            rms_row_bf16(xr, a.in[I_MIXN], H + (size_t)r * D, lane);
        }
    }
    GSYNC();
    if (PHMASK & 16) { EpiProj E; E.O = Pm; E.IFp = IFp; run_gemm(lds, H, (const bf16_t*)(a.ws + WS_WIN), MA, PLD, 2048, E);
        PH_IDS conv_ffn2_range(a, lds, 0, FFN2_CAP, gw, ngw, wave, lane, (unsigned*)a.ws + 24); }
    GSYNC();
    if (G == 256) {
        if (blockIdx.x < 128) rwkv_task(a, lds, 0, blockIdx.x >> 4, blockIdx.x & 15);
        else {
            const int r0 = blockIdx.x - 128;
            mlstm_task(a, lds, 0, r0 >> 4, (r0 >> 2) & 3, r0 & 3);
            for (int k = 0; k < 4; ++k) { const int r = r0 + 128 * k; rwkv_task(a, lds, 1, r >> 4, r & 15); }
            for (int k = 0; k < 4; ++k) { const int r = r0 + 128 * k; mlstm_task(a, lds, 1, r >> 4, (r >> 2) & 3, r & 3); }
        }
    } else
    for (int task = blockIdx.x; task < 1280; task += G) {
#if !defined(NO_RW)
        if (task < 128) rwkv_task(a, lds, 0, task >> 4, task & 15);
        else if (task >= 256 && task < 768) { const int r = task - 256; rwkv_task(a, lds, 1, r >> 4, r & 15); }
#endif
#if !defined(NO_ML)
        if (task >= 128 && task < 256) { const int r = task - 128; mlstm_task(a, lds, 0, r >> 4, (r >> 2) & 3, r & 3); }
        else if (task >= 768) { const int r = task - 768; mlstm_task(a, lds, 1, r >> 4, (r >> 2) & 3, r & 3); }
#endif
    }
    GSYNC();
    if (PHMASK & 128) { EpiGate E; E.O = Gt; run_gemm(lds, H, (const bf16_t*)(a.ws + WS_WGATE), MC, 4096, 2048, E); }
    { PH_IDS int it; for (ItemIt ii((unsigned*)a.ws + 40, MC, gw, ngw, lane, 8); ii.next(it); ) {
        const int row = it;
        bf16_t* hp = YML + (size_t)row * 1024 + lane * 4; const bf16_t* op = Pm + (size_t)row * PLD + P_O + lane * 4;
        u32x2 hv[4], ov[4]; f32x4 nw[4];
#pragma unroll
        for (int hd = 0; hd < 4; ++hd) { hv[hd] = *(const u32x2*)(hp + hd * 256); ov[hd] = *(const u32x2*)(op + hd * 256); nw[hd] = *(const f32x4*)(a.in[I_MNW] + hd * 256 + lane * 4); }
        float hx[4][4], mean[4], var[4];
#pragma unroll
        for (int hd = 0; hd < 4; ++hd) { hx[hd][0] = bf_lo(hv[hd].x); hx[hd][1] = bf_hi(hv[hd].x); hx[hd][2] = bf_lo(hv[hd].y); hx[hd][3] = bf_hi(hv[hd].y); mean[hd] = (hx[hd][0] + hx[hd][1]) + (hx[hd][2] + hx[hd][3]); }
#pragma unroll
        for (int o = 1; o < 64; o <<= 1) {
#pragma unroll
            for (int hd = 0; hd < 4; ++hd) mean[hd] += __shfl_xor(mean[hd], o); }
#pragma unroll
        for (int hd = 0; hd < 4; ++hd) { mean[hd] *= (1.f / 256.f); float q = 0.f;
#pragma unroll
            for (int e = 0; e < 4; ++e) { hx[hd][e] -= mean[hd]; q += hx[hd][e] * hx[hd][e]; }
            var[hd] = q; }
#pragma unroll
        for (int o = 1; o < 64; o <<= 1) {
#pragma unroll
            for (int hd = 0; hd < 4; ++hd) var[hd] += __shfl_xor(var[hd], o); }
#pragma unroll
        for (int hd = 0; hd < 4; ++hd) { const float rs = rsqrtf(var[hd] * (1.f / 256.f) + 1e-5f);
            u32x2 w; w.x = pk2(hx[hd][0] * rs * nw[hd][0] * sigm(bf_lo(ov[hd].x)), hx[hd][1] * rs * nw[hd][1] * sigm(bf_hi(ov[hd].x)));
            w.y = pk2(hx[hd][2] * rs * nw[hd][2] * sigm(bf_lo(ov[hd].y)), hx[hd][3] * rs * nw[hd][3] * sigm(bf_hi(ov[hd].y)));
            *(u32x2*)(hp + hd * 256) = w; }
    } }
    GSYNC();
    if (PHMASK & 256) { EpiBr<true> E; E.G = Gt; E.O = MRG; E.goff = 0; run_gemm(lds, YRW, (const bf16_t*)(a.ws + WS_WBRRW), MC, 2048, 1024, E); }
    if (PHMASK & 256) { EpiBr<false> E; E.G = Gt; E.O = MRG; E.goff = 2048; run_gemm(lds, YML, (const bf16_t*)(a.ws + WS_WBRML), MC, 2048, 1024, E); }
    GSYNC();
#if DIAG_SIMPLE & 2
    simple_gemm(MRG, (const bf16_t*)(a.ws + WS_WOUT), MC, 2048, 2048, gw, ngw, lane, [&](int r, int c, float v) { X[(size_t)r * D + c] += v; });
#else
    if (PHMASK & 512) { EpiOut E; E.X = X; run_gemm(lds, MRG, (const bf16_t*)(a.ws + WS_WOUT), MC, 2048, 2048, E);
        PH_IDS conv_ffn2_range(a, lds, FFN2_CAP, 22144, gw, ngw, wave, lane, (unsigned*)a.ws + 32); }
#endif
    GSYNC();
    if (PHMASK & 1024) { PH_IDS
        if ((NPR % (2 * ngw)) == 0) for (int r = gw; r < NPR; r += 2 * ngw) rms_row2_bf16(X + (size_t)r * D, X + (size_t)(r + ngw) * D, a.in[I_F2N], H + (size_t)r * D, H + (size_t)(r + ngw) * D, lane);
        for (int r = ((NPR % (2 * ngw)) == 0 ? NPR : 0) + gw; r < MC; r += ngw) rms_row_bf16(X + (size_t)r * D, a.in[I_F2N], H + (size_t)r * D, lane); }
    GSYNC();
    if (PHMASK & 2048) { EpiGU E; E.O = HID; E.AS = (bf16_t*)(a.ws + WS_AS); run_gemm(lds, H, (const bf16_t*)(a.ws + WS_WGU), MC, 11008, 2048, E); }
    GSYNC();
#if DIAG_SIMPLE & 4
    simple_gemm(HID, (const bf16_t*)(a.ws + WS_WD), MC, 2048, FF, gw, ngw, lane, [&](int r, int c, float v) { X[(size_t)r * D + c] += 0.5f * v; });
#else
    if (PHMASK & 4096) { EpiDown E; E.in0 = X; E.in1 = X + (size_t)128 * 256 * D; E.in2 = xinm; E.o0 = X; E.o2 = xmeta; run_gemm(lds, HID, (const bf16_t*)(a.ws + WS_WD), NPR, 2048, FF, E);
        run_tail_gemm(lds, (const bf16_t*)(a.ws + WS_AS), (const bf16_t*)(a.ws + WS_BS), (float*)(a.ws + WS_PART), 2); }
#endif
    GSYNC();
    if (PHMASK & 8192) { PH_IDS
        if ((NPR % (2 * ngw)) == 0) for (int r = gw; r < NPR; r += 2 * ngw) rms_row2_f32(X + (size_t)r * D, X + (size_t)(r + ngw) * D, a.in[I_FN], lane);
        for (int r = ((NPR % (2 * ngw)) == 0 ? NPR : 0) + gw; r < MC; r += ngw) {
        float* xr = X + (size_t)r * D;
        if (r >= NPR) { const float* pp = (const float*)(a.ws + WS_PART) + (size_t)(r - NPR) * D;
#pragma unroll
            for (int j = 0; j < 8; ++j) { const int e = lane + 64 * j; f32x4 v = ((const f32x4*)pp)[e];
#pragma unroll
                for (int q = 1; q < NSL; ++q) v += ((const f32x4*)(pp + (size_t)q * TAILR * D))[e];
                ((f32x4*)xr)[e] = ((const f32x4*)xr)[e] + 0.5f * v; } }
        rms_row_f32(xr, a.in[I_FN], lane, r >= NPR ? DBG_SYS : 1.f);
    } }
}

extern "C" void kernel_launch(void* const* d_in, const int* in_sizes, int n_in, void* d_out, int out_size, void* d_ws, size_t ws_size, hipStream_t stream) {
    static int grid = 0;
    if (grid == 0) {
        if (n_in != N_IN || (size_t)out_size != O_END || ws_size < WS_END) { fprintf(stderr, "kernel_launch: unexpected shapes: n_in %d out %d ws %zu (need %zu)\n", n_in, out_size, ws_size, (size_t)WS_END); grid = -1; return; }
        int dev = 0, cus = 0, per_cu = 0;
        hipGetDevice(&dev);
        hipDeviceGetAttribute(&cus, hipDeviceAttributeMultiprocessorCount, dev);
        if (hipFuncSetAttribute((const void*)mk_fwd, hipFuncAttributeMaxDynamicSharedMemorySize, LDS_BYTES) != hipSuccess) { fprintf(stderr, "kernel_launch: hipFuncSetAttribute failed\n"); grid = -1; return; }
        if (hipOccupancyMaxActiveBlocksPerMultiprocessor(&per_cu, (const void*)mk_fwd, 512, LDS_BYTES) != hipSuccess || per_cu < 1) { fprintf(stderr, "kernel_launch: occupancy query says %d\n", per_cu); per_cu = 1; }
        (void)hipGetLastError();
        grid = cus * per_cu;
    }
    if (grid < 0) return;
    if (hipMemsetAsync(d_ws, 0, 4096, stream) != hipSuccess) { fprintf(stderr, "kernel_launch: memset failed\n"); return; }
    Args a{};
    for (int i = 0; i < N_IN; ++i) a.in[i] = (const float*)d_in[i];
    a.out = (float*)d_out; a.ws = (unsigned char*)d_ws;
    void* args[] = {&a};
    hipError_t e = hipLaunchCooperativeKernel((const void*)mk_fwd, dim3(grid), dim3(512), args, LDS_BYTES, stream);
    if (e != hipSuccess) fprintf(stderr, "cooperative launch failed: %s (grid %d)\n", hipGetErrorString(e), grid);
}
```

```cpp
#include <hip/hip_runtime.h>
#include <hip/hip_cooperative_groups.h>
#include <cstdio>
#include <cstdint>
namespace cg = cooperative_groups;
#define DI __device__ __forceinline__
#define LAS __attribute__((address_space(3)))
namespace pg8 {
#define PG8_LAS __attribute__((address_space(3)))
typedef unsigned short bf16_t;
typedef short bf16x8 __attribute__((ext_vector_type(8)));
typedef float f32x4 __attribute__((ext_vector_type(4)));
typedef unsigned u32x4 __attribute__((ext_vector_type(4)));
constexpr int BM = 256, BK = 64, HALF = 128, HTB = HALF * BK * 2  , STAGE_BYTES = 8 * HTB, NXCD = 8, WGM = 8;

__host__ __device__ __forceinline__ int lds_byte(int r, int c) { const int st = (r >> 4) * 2 + (c >> 5), rr = r & 15, cc = c & 31, ob = rr * 64 + cc * 2; return st * 1024 + (ob ^ (((ob >> 9) & 1) << 5)); }
__host__ __device__ __forceinline__ void stage_rc(int b, int& R, int& C) { const int st = b / 1024, sb = b % 1024, swz = sb ^ (((sb >> 9) & 1) << 5); R = (st >> 1) * 16 + swz / 64; C = (st & 1) * 32 + (swz % 64) / 2; }
__host__ __device__ __forceinline__ int perm32(int rho) { const int n = rho >> 4, i = rho & 15; return 8 * (i >> 2) + 4 * n + (i & 3); }

struct Unit { int pm, pn; };
struct Gemm { const bf16_t* A; const bf16_t* Bt; int M, N, K; };

struct StaticOrder {
    int nM, nN, nwg, G, c;
    __host__ __device__ void init(int M, int N, int G_, int c_) { nM = M / BM; nN = N / BM; nwg = nM * nN; G = G_; c = c_; }
    __host__ __device__ bool next(int i, Unit& u) const {
        const long L = (long)i * G + c; if (L >= nwg) return false;
        int wgid = (int)L; { const int q = nwg / NXCD, r = nwg % NXCD, xcd = wgid % NXCD, off = wgid / NXCD; wgid = (xcd < r ? xcd * (q + 1) : r * (q + 1) + (xcd - r) * q) + off; }
        const int nig = WGM * nN, gid = wgid / nig, fm = gid * WGM, gsz = (nM - fm) < WGM ? (nM - fm) : WGM;
        u.pm = fm + ((wgid % nig) % gsz); u.pn = (wgid % nig) / gsz; return true;
    }
    __device__ __forceinline__ void a_ready(const Unit&) const {}
    __device__ __forceinline__ void done(const Unit&) const {}
};
__device__ __forceinline__ unsigned cvt_pk_bf16(float lo, float hi) { unsigned r; asm volatile("v_cvt_pk_bf16_f32 %0, %1, %2" : "=v"(r) : "v"(lo), "v"(hi)); return r; }
template <class Epi, class Sched, bool STAMP = false>
__device__ __forceinline__ void gemm_phase(PG8_LAS unsigned char* lds, const Gemm g, const Sched& S, const Epi& E, unsigned long long* stamps) {
    int tid_ = threadIdx.x; asm volatile("" : "+v"(tid_));
    const int tid = tid_, wid = __builtin_amdgcn_readfirstlane(tid >> 6), lane = tid & 63, wr = wid >> 2, wc = wid & 3, fr = lane & 15, fq = lane >> 4;
    const int K = g.K, nt = K / BK;
    int ts_lo = 0, ts_hi = 0, nts = 0; const unsigned long long rt_entry = STAMP ? (unsigned long long)wall_clock64() : 0ull;
#define PG8_STAMP() do { if (STAMP && wid == 0 && nts < 64) { const unsigned long long _c = (unsigned long long)clock64(); \
        ts_lo = (lane == nts) ? (int)(unsigned)_c : ts_lo; ts_hi = (lane == nts) ? (int)(unsigned)(_c >> 32) : ts_hi; ++nts; } } while (0)
    PG8_STAMP();
    unsigned voffA[2], voffB[2];
#pragma unroll
    for (int i = 0; i < 2; ++i) { int R, C; stage_rc(tid * 16 + i * 8192, R, C); const int Rb = Epi::PERM ? ((R & ~31) + perm32(R & 31)) : R;
        voffA[i] = (unsigned)(R * K + C) * 2u; voffB[i] = (unsigned)(Rb * K + C) * 2u; }
    const size_t kstep = (size_t)(BK * 2);
    const size_t hstep = (size_t)HALF * K * 2;
    const size_t tstep = 2 * hstep;
    const unsigned ldsw = (unsigned)wid * 1024u;
    const int aoff = lds_byte(wr * 64 + fr, fq * 8), boff = lds_byte(wc * 32 + fr, fq * 8);
#define PG8_SA(b, h) (((b) * 2 + (h)) * HTB)
#define PG8_SB(b, h) ((4 + (b) * 2 + (h)) * HTB)
#define PG8_STAGE(bufoff, gbase, voff) do { _Pragma("unroll") for (int _i = 0; _i < 2; ++_i) \
        __builtin_amdgcn_global_load_lds((const unsigned*)((const char*)(gbase) + (voff)[_i]), (PG8_LAS unsigned*)(lds + (bufoff) + ldsw + _i * 8192), 16, 0, 0); } while (0)
#define PG8_LDA(dst, b, h) do { _Pragma("unroll") for (int m = 0; m < 4; ++m) _Pragma("unroll") for (int k = 0; k < 2; ++k) dst[m][k] = *(const PG8_LAS bf16x8*)(lds + PG8_SA(b, h) + aoff + m * 2048 + k * 1024); } while (0)
#define PG8_LDB(dst, b, h) do { _Pragma("unroll") for (int n = 0; n < 2; ++n) _Pragma("unroll") for (int k = 0; k < 2; ++k) dst[n][k] = *(const PG8_LAS bf16x8*)(lds + PG8_SB(b, h) + boff + n * 2048 + k * 1024); } while (0)
#define PG8_MMA(ai, bj, At, Bt) do { __builtin_amdgcn_s_setprio(1); _Pragma("unroll") for (int m = 0; m < 4; ++m) _Pragma("unroll") for (int n = 0; n < 2; ++n) _Pragma("unroll") for (int k = 0; k < 2; ++k) \
        acc[ai][bj][m][n] = __builtin_amdgcn_mfma_f32_16x16x32_bf16(Bt[n][k], At[m][k], acc[ai][bj][m][n], 0, 0, 0); __builtin_amdgcn_s_setprio(0); } while (0)
#define PG8_WAIT_V(n) asm volatile("s_waitcnt vmcnt(" #n ")" ::: "memory")
#define PG8_WAIT_L(n) asm volatile("s_waitcnt lgkmcnt(" #n ")" ::: "memory")
#define PG8_BAR __builtin_amdgcn_s_barrier()
#define PG8_SCHED __builtin_amdgcn_sched_barrier(0)
    Unit cur, nxt; int ui = 0;
    if (!S.next(0, cur)) return;
    f32x4 acc[2][2][4][2];
#pragma unroll
    for (int a = 0; a < 2; ++a)
#pragma unroll
        for (int b = 0; b < 2; ++b)
#pragma unroll
            for (int m = 0; m < 4; ++m)
#pragma unroll
                for (int n = 0; n < 2; ++n) acc[a][b][m][n] = (f32x4){0.f, 0.f, 0.f, 0.f};
    bf16x8 At[4][2], B0[2][2], B1[2][2];
    const char* cA = (const char*)g.A + (size_t)cur.pm * tstep; const char* cB = (const char*)g.Bt + (size_t)cur.pn * tstep;
    S.a_ready(cur);
    PG8_STAGE(PG8_SB(0, 0), cB, voffB); PG8_STAGE(PG8_SA(0, 0), cA, voffA); PG8_STAGE(PG8_SB(0, 1), cB + hstep, voffB); PG8_STAGE(PG8_SA(0, 1), cA + hstep, voffA);
    if (wr == 1) PG8_BAR;
    PG8_WAIT_V(4); PG8_BAR;
    PG8_STAGE(PG8_SB(1, 0), cB + kstep, voffB); PG8_STAGE(PG8_SA(1, 0), cA + kstep, voffA); PG8_STAGE(PG8_SB(1, 1), cB + hstep + kstep, voffB);
    PG8_WAIT_V(6); PG8_BAR;
    PG8_STAMP();
    for (;;) {
        const bool has_next = S.next(ui + 1, nxt);
        const char* nA = has_next ? (const char*)g.A + (size_t)nxt.pm * tstep : cA; const char* nB = has_next ? (const char*)g.Bt + (size_t)nxt.pn * tstep : cB;
        for (int t = 0; t < nt; t += 2) {
            const bool last = (t == nt - 2);
            const char* a1 = cA + (size_t)(t + 1) * kstep;
            const char* a2 = last ? nA : cA + (size_t)(t + 2) * kstep; const char* b2 = last ? nB : cB + (size_t)(t + 2) * kstep;
            const char* a3 = a2 + kstep; const char* b3 = b2 + kstep;
            if (last && has_next) S.a_ready(nxt);
            PG8_LDB(B0, 0, 0); PG8_SCHED; PG8_LDA(At, 0, 0); PG8_STAGE(PG8_SA(1, 1), a1 + hstep, voffA);
            PG8_WAIT_L(8); PG8_BAR; PG8_WAIT_L(0); PG8_MMA(0, 0, At, B0); PG8_BAR; PG8_SCHED;
            PG8_LDB(B1, 0, 1); PG8_STAGE(PG8_SB(0, 0), b2, voffB);
            PG8_BAR; PG8_WAIT_L(0); PG8_MMA(0, 1, At, B1); PG8_BAR;
            PG8_LDA(At, 0, 1); PG8_STAGE(PG8_SA(0, 0), a2, voffA);
            PG8_BAR; PG8_WAIT_L(0); PG8_MMA(1, 0, At, B0); PG8_BAR; PG8_SCHED;
            PG8_STAGE(PG8_SB(0, 1), b2 + hstep, voffB);
            PG8_WAIT_V(6); PG8_BAR; PG8_MMA(1, 1, At, B1); PG8_BAR;
            PG8_LDB(B0, 1, 0); PG8_SCHED; PG8_LDA(At, 1, 0); PG8_STAGE(PG8_SA(0, 1), a2 + hstep, voffA);
            PG8_WAIT_L(8); PG8_BAR; PG8_WAIT_L(0); PG8_MMA(0, 0, At, B0); PG8_BAR; PG8_SCHED;
            PG8_LDB(B1, 1, 1); PG8_STAGE(PG8_SB(1, 0), b3, voffB);
            PG8_BAR; PG8_WAIT_L(0); PG8_MMA(0, 1, At, B1); PG8_BAR;
            PG8_LDA(At, 1, 1); PG8_STAGE(PG8_SA(1, 0), a3, voffA);
            PG8_BAR; PG8_WAIT_L(0); PG8_MMA(1, 0, At, B0); PG8_BAR; PG8_SCHED;
            PG8_STAGE(PG8_SB(1, 1), b3 + hstep, voffB);
            PG8_WAIT_V(6); PG8_BAR; PG8_MMA(1, 1, At, B1); PG8_BAR;
        }
        PG8_STAMP();
        if constexpr (!Epi::AFTER_DRAIN) { E(acc, cur, wr, wc, fr, fq); S.done(cur); }
        PG8_STAMP();
        if (!has_next) break;
#pragma unroll
        for (int a = 0; a < 2; ++a)
#pragma unroll
            for (int b = 0; b < 2; ++b)
#pragma unroll
                for (int m = 0; m < 4; ++m)
#pragma unroll
                    for (int n = 0; n < 2; ++n) acc[a][b][m][n] = (f32x4){0.f, 0.f, 0.f, 0.f};
        cur = nxt; cA = nA; cB = nB; ++ui;
    }
    PG8_WAIT_V(0);
    if (wr == 0) PG8_BAR;
    PG8_BAR;
    if constexpr (Epi::AFTER_DRAIN) { E.fused(acc, cur, wr, wc, fr, fq, lds, wid, lane); S.done(cur); }
    PG8_STAMP();
    if (STAMP && wid == 0) { stamps[lane] = lane < nts ? (((unsigned long long)(unsigned)ts_hi << 32) | (unsigned)ts_lo) : 0ull;
        if (lane == 62) stamps[62] = rt_entry; if (lane == 63) stamps[63] = (unsigned long long)wall_clock64(); }
#undef PG8_STAMP
#undef PG8_SA
#undef PG8_SB
#undef PG8_STAGE
#undef PG8_LDA
#undef PG8_LDB
#undef PG8_MMA
#undef PG8_WAIT_V
#undef PG8_WAIT_L
#undef PG8_BAR
#undef PG8_SCHED
}
}
using namespace pg8;
#ifndef DBG_SYS
#define DBG_SYS 1.0f
#endif
#ifndef DBG_KRW
#define DBG_KRW 1.0f
#endif
#ifndef DBG_KML
#define DBG_KML 1.0f
#endif
#ifndef DBG_SY
#define DBG_SY 1.0f
#endif
#ifndef DBG_SR
#define DBG_SR 1.0f
#endif
#ifndef DBG_SM
#define DBG_SM 1.0f
#endif
typedef unsigned u32x2 __attribute__((ext_vector_type(2)));

constexpr int D = 2048, FF = 5504;
constexpr int NPR = 32768, NREAL = 33280, MA = 33536, MC = 33280, MA_REAL = 33296;
constexpr int PLD = 7680, P_IF = 3360, P_QK = 3584, P_V = 5632, P_O = 6656;
enum { I_XP = 0, I_XS, I_SSHIFT, I_SWKV, I_SCONV, I_SC, I_SN, I_SM, I_META, I_F1N, I_F1G, I_F1U, I_F1D, I_MIXN, I_WIN, I_MU, I_W0, I_W2, I_A0, I_A2, I_G2, I_KK, I_KA, I_RK,
       I_LNW, I_LNB, I_CW, I_CB, I_IB, I_FB, I_MNW, I_BRRW, I_BRML, I_WOUT, I_F2N, I_F2G, I_F2U, I_F2D, I_FN, N_IN };
constexpr size_t O_YP = 0, O_YS = 67108864, O_PSHIFT = 68157440, O_PWKV = O_PSHIFT + 26880, O_PCONV = O_PWKV + 524288, O_PC = O_PCONV + 49152, O_PN = O_PC + 2097152,
                 O_PM = O_PN + 8192, O_SSHIFT = O_PM + 32, O_SWKV = O_SSHIFT + 107520, O_SCONV = O_SWKV + 2097152, O_SC = O_SCONV + 196608, O_SN = O_SC + 8388608,
                 O_SM = O_SN + 32768, O_END = O_SM + 128;
constexpr size_t al256(size_t x) { return (x + 255) & ~size_t(255); }
constexpr size_t WS_XINM = 4096;
constexpr size_t WS_XMETA = WS_XINM + 256 * 2048 * 4;
constexpr size_t WS_IF = WS_XMETA + 256 * 2048 * 4;
constexpr size_t WS_WGU = al256(WS_IF + (size_t)MA * 8 * 4);
constexpr size_t WS_WD = WS_WGU + (size_t)11008 * 2048 * 2;
constexpr size_t WS_WIN = WS_WD + (size_t)2048 * 5504 * 2;
constexpr size_t WS_WGATE = WS_WIN + (size_t)7680 * 2048 * 2;
constexpr size_t WS_WBRRW = WS_WGATE + (size_t)4096 * 2048 * 2;
constexpr size_t WS_WBRML = WS_WBRRW + (size_t)2048 * 1024 * 2;
constexpr size_t WS_WOUT = WS_WBRML + (size_t)2048 * 1024 * 2;
constexpr size_t WS_W2T = WS_WOUT + (size_t)2048 * 2048 * 2;
constexpr size_t WS_A2T = WS_W2T + 1024 * 64 * 2;
constexpr size_t WS_G2T = WS_A2T + 1024 * 64 * 2;
constexpr size_t WS_H = al256(WS_G2T + 1024 * 160 * 2);
constexpr size_t WS_YRW = WS_H + (size_t)MA * 2048 * 2;
constexpr size_t WS_YML = WS_YRW + (size_t)MC * 1024 * 2;
constexpr size_t WS_P = WS_YML + (size_t)MC * 1024 * 2;
constexpr int KS = 1408, NSL = 4, TAILR = 768;
constexpr size_t WS_AS = WS_P + (size_t)MA * PLD * 2;
constexpr size_t WS_BS = WS_AS + (size_t)NSL * TAILR * KS * 2;
constexpr size_t WS_PART = WS_BS + (size_t)NSL * 2048 * KS * 2;
constexpr size_t WS_END = WS_PART + (size_t)NSL * TAILR * 2048 * 4;
constexpr int LDS_BYTES = 160 * 1024;

struct Args { const float* in[N_IN]; float* out; unsigned char* ws; };

typedef __bf16 bf16n2 __attribute__((ext_vector_type(2)));
typedef float f32n2 __attribute__((ext_vector_type(2)));
DI unsigned pk2(float lo, float hi) { const f32n2 v = {lo, hi}; return __builtin_bit_cast(unsigned, __builtin_convertvector(v, bf16n2)); }
DI float bf_lo(unsigned u) { return __uint_as_float(u << 16); }
DI float bf_hi(unsigned u) { return __uint_as_float(u & 0xffff0000u); }
DI float sigm(float x) { return __builtin_amdgcn_rcpf(1.f + __expf(-x)); }
DI float wave_sum(float v) {
#pragma unroll
    for (int o = 1; o < 64; o <<= 1) v += __shfl_xor(v, o);
    return v;
}
#define LDS_WAIT() asm volatile("s_waitcnt lgkmcnt(0)" ::: "memory")
template <int CTRL> DI float dppf(float s) { return __builtin_bit_cast(float, __builtin_amdgcn_update_dpp(0, __builtin_bit_cast(int, s), CTRL, 0xF, 0xF, true)); }
DI float sum8(float s) { s += dppf<0xB1>(s); s += dppf<0x4E>(s); s += dppf<0x141>(s); return s; }
DI float sum16(float s) { s = sum8(s); s += dppf<0x140>(s); return s; }
DI void unpack8(const u32x4 v, float (&f)[8]) { f[0] = bf_lo(v.x); f[1] = bf_hi(v.x); f[2] = bf_lo(v.y); f[3] = bf_hi(v.y); f[4] = bf_lo(v.z); f[5] = bf_hi(v.z); f[6] = bf_lo(v.w); f[7] = bf_hi(v.w); }

struct EpiGU {
    static constexpr bool PERM = true, AFTER_DRAIN = false;
    bf16_t* O; bf16_t* AS;
    DI void operator()(const f32x4 (&acc)[2][2][4][2], const Unit& u, int wr, int wc, int fr, int fq) const {
        const int row0 = u.pm * 256 + wr * 64 + fr, col0 = u.pn * 128 + wc * 32 + 8 * fq;
        const int sl = u.pn / 11, cl = (u.pn % 11) * 128 + wc * 32 + 8 * fq;
#pragma unroll
        for (int ai = 0; ai < 2; ++ai)
#pragma unroll
            for (int m = 0; m < 4; ++m) {
                const int rr = row0 + ai * 128 + m * 16;
                bf16_t* rowp = (u.pm >= 128) ? AS + ((size_t)sl * TAILR + (rr - NPR)) * KS + cl : O + (size_t)rr * FF + col0;
                float v[8];
#pragma unroll
                for (int n = 0; n < 2; ++n)
#pragma unroll
                    for (int j = 0; j < 4; ++j) { const float g = acc[ai][0][m][n][j], up = acc[ai][1][m][n][j]; v[n * 4 + j] = g * sigm(g) * up; }
                u32x4 w; w.x = pk2(v[0], v[1]); w.y = pk2(v[2], v[3]); w.z = pk2(v[4], v[5]); w.w = pk2(v[6], v[7]);
                *(u32x4*)rowp = w;
            }
    }
};
struct EpiDown {
    static constexpr bool PERM = true, AFTER_DRAIN = false;
    const float *in0, *in1, *in2; float *o0, *o2;
    DI void operator()(const f32x4 (&acc)[2][2][4][2], const Unit& u, int wr, int wc, int fr, int fq) const {
        const float* ib = u.pm < 128 ? in0 + (size_t)u.pm * 256 * D : (u.pm < 130 ? in1 + (size_t)(u.pm - 128) * 256 * D : in2);
        float* ob = u.pm < 130 ? o0 + (size_t)u.pm * 256 * D : o2;
        const int rl0 = wr * 64 + fr, col0 = u.pn * 256 + wc * 32 + 8 * fq;
#pragma unroll
        for (int ai = 0; ai < 2; ++ai)
#pragma unroll
            for (int m = 0; m < 4; ++m) {
                const size_t off = (size_t)(rl0 + ai * 128 + m * 16) * D + col0;
#pragma unroll
                for (int bj = 0; bj < 2; ++bj)
#pragma unroll
                    for (int n = 0; n < 2; ++n) { const f32x4 xi = *(const f32x4*)(ib + off + bj * 128 + n * 4); *(f32x4*)(ob + off + bj * 128 + n * 4) = xi + 0.5f * acc[ai][bj][m][n]; }
            }
    }
};
struct EpiProj {
    static constexpr bool PERM = true, AFTER_DRAIN = false;
    bf16_t* O; float* IFp;
    DI void operator()(const f32x4 (&acc)[2][2][4][2], const Unit& u, int wr, int wc, int fr, int fq) const {
        const int row0 = u.pm * 256 + wr * 64 + fr, col0 = u.pn * 256 + wc * 32 + 8 * fq;
        const bool ifl = (u.pn == 13) && (wc == 1) && (fq == 0);
#pragma unroll
        for (int ai = 0; ai < 2; ++ai)
#pragma unroll
            for (int m = 0; m < 4; ++m) {
                const int r = row0 + ai * 128 + m * 16;
                bf16_t* rowp = O + (size_t)r * PLD + col0;
#pragma unroll
                for (int bj = 0; bj < 2; ++bj) { const f32x4 v0 = acc[ai][bj][m][0], v1 = acc[ai][bj][m][1];
                    u32x4 w; w.x = pk2(v0[0], v0[1]); w.y = pk2(v0[2], v0[3]); w.z = pk2(v1[0], v1[1]); w.w = pk2(v1[2], v1[3]);
                    *(u32x4*)(rowp + bj * 128) = w; }
                if (ifl) { *(f32x4*)(IFp + (size_t)r * 8) = acc[ai][0][m][0]; *(f32x4*)(IFp + (size_t)r * 8 + 4) = acc[ai][0][m][1]; }
            }
    }
};
struct EpiGate {
    static constexpr bool PERM = true, AFTER_DRAIN = false;
    bf16_t* O;
    DI void operator()(const f32x4 (&acc)[2][2][4][2], const Unit& u, int wr, int wc, int fr, int fq) const {
        const int row0 = u.pm * 256 + wr * 64 + fr, col0 = u.pn * 256 + wc * 32 + 8 * fq;
#pragma unroll
        for (int ai = 0; ai < 2; ++ai)
#pragma unroll
            for (int m = 0; m < 4; ++m) {
                bf16_t* rowp = O + (size_t)(row0 + ai * 128 + m * 16) * PLD + col0;
#pragma unroll
                for (int bj = 0; bj < 2; ++bj) { const f32x4 v0 = acc[ai][bj][m][0], v1 = acc[ai][bj][m][1];
                    u32x4 w; w.x = pk2(sigm(v0[0]), sigm(v0[1])); w.y = pk2(sigm(v0[2]), sigm(v0[3])); w.z = pk2(sigm(v1[0]), sigm(v1[1])); w.w = pk2(sigm(v1[2]), sigm(v1[3]));
                    *(u32x4*)(rowp + bj * 128) = w; }
            }
    }
};
template <bool FIRST> struct EpiBr {
    static constexpr bool PERM = true, AFTER_DRAIN = false;
    const bf16_t* G; bf16_t* O; int goff;
    DI void operator()(const f32x4 (&acc)[2][2][4][2], const Unit& u, int wr, int wc, int fr, int fq) const {
        const int row0 = u.pm * 256 + wr * 64 + fr, col0 = u.pn * 256 + wc * 32 + 8 * fq;
#pragma unroll
        for (int ai = 0; ai < 2; ++ai)
#pragma unroll
            for (int m = 0; m < 4; ++m) {
                const int r = row0 + ai * 128 + m * 16;
#pragma unroll
                for (int bj = 0; bj < 2; ++bj) {
                    float g[8], o[8];
                    unpack8(*(const u32x4*)(G + (size_t)r * PLD + goff + col0 + bj * 128), g);
                    bf16_t* op = O + (size_t)r * D + col0 + bj * 128;
                    if (FIRST) {
#pragma unroll
                        for (int j = 0; j < 8; ++j) o[j] = 0.f;
                    } else unpack8(*(const u32x4*)op, o);
#pragma unroll
                    for (int n = 0; n < 2; ++n)
#pragma unroll
                        for (int j = 0; j < 4; ++j) o[n * 4 + j] += (FIRST ? DBG_KRW : DBG_KML) * g[n * 4 + j] * acc[ai][bj][m][n][j];
                    u32x4 w; w.x = pk2(o[0], o[1]); w.y = pk2(o[2], o[3]); w.z = pk2(o[4], o[5]); w.w = pk2(o[6], o[7]);
                    *(u32x4*)op = w;
                }
            }
    }
};
struct EpiOut {
    static constexpr bool PERM = true, AFTER_DRAIN = false;
    float* X;
    DI void operator()(const f32x4 (&acc)[2][2][4][2], const Unit& u, int wr, int wc, int fr, int fq) const {
        const int row0 = u.pm * 256 + wr * 64 + fr, col0 = u.pn * 256 + wc * 32 + 8 * fq;
#pragma unroll
        for (int ai = 0; ai < 2; ++ai)
#pragma unroll
            for (int m = 0; m < 4; ++m) {
                float* rowp = X + (size_t)(row0 + ai * 128 + m * 16) * D + col0;
#pragma unroll
                for (int bj = 0; bj < 2; ++bj)
#pragma unroll
                    for (int n = 0; n < 2; ++n) { f32x4* p = (f32x4*)(rowp + bj * 128 + n * 4); *p = *p + acc[ai][bj][m][n]; }
            }
    }
};
struct EpiPart {
    static constexpr bool PERM = true, AFTER_DRAIN = false;
    float* Pp;
    DI void operator()(const f32x4 (&acc)[2][2][4][2], const Unit& u, int wr, int wc, int fr, int fq) const {
        const int sl = u.pm / 3, pmr = u.pm % 3, pnr = u.pn & 7;
        const int row0 = pmr * 256 + wr * 64 + fr, col0 = pnr * 256 + wc * 32 + 8 * fq;
#pragma unroll
        for (int ai = 0; ai < 2; ++ai)
#pragma unroll
            for (int m = 0; m < 4; ++m) {
                float* rowp = Pp + ((size_t)sl * TAILR + row0 + ai * 128 + m * 16) * D + col0;
#pragma unroll
                for (int bj = 0; bj < 2; ++bj)
#pragma unroll
                    for (int n = 0; n < 2; ++n) *(f32x4*)(rowp + bj * 128 + n * 4) = acc[ai][bj][m][n];
            }
    }
};
struct TailOrder {
    int ntile, c;
    __device__ bool next(int i, Unit& u) const {
        if (i > 0 || c >= NSL * ntile * 8) return false;
        const int sl = c / (ntile * 8), rem = c % (ntile * 8);
        u.pm = sl * 3 + rem / 8; u.pn = sl * 8 + (rem & 7); return true;
    }
    __device__ __forceinline__ void a_ready(const Unit&) const {}
    __device__ __forceinline__ void done(const Unit&) const {}
};
DI void run_tail_gemm(LAS unsigned char* lds, const bf16_t* AS, const bf16_t* BS, float* Pp, int ntile) {
    Gemm g; g.A = AS; g.Bt = BS; g.M = NSL * TAILR; g.N = NSL * 2048; g.K = KS;
    TailOrder S; S.ntile = ntile; S.c = (int)blockIdx.x;
    EpiPart E; E.Pp = Pp;
    gemm_phase<EpiPart, TailOrder, false>(lds, g, S, E, nullptr);
}
template <class Epi> DI void run_gemm(LAS unsigned char* lds, const bf16_t* A, const bf16_t* Bt, int M, int N, int K, const Epi& E) {
    Gemm g; g.A = A; g.Bt = Bt; g.M = M; g.N = N; g.K = K;
    StaticOrder S; S.init(M, N, (int)gridDim.x, (int)blockIdx.x);
    gemm_phase<Epi, StaticOrder, false>(lds, g, S, E, nullptr);
}

DI void tr_item(const float* W, int K, int Nsrc, bf16_t* WT, int k0, int n0d, int n0s, int nvalid, LAS float* scr, int lane) {
    const int c = lane & 31;
#pragma unroll
    for (int i = 0; i < 32; ++i) { const int kk = 2 * i + (lane >> 5); scr[kk * 33 + c] = (c < nvalid) ? W[(size_t)(k0 + kk) * Nsrc + n0s + c] : 0.f; }
    LDS_WAIT();
    const int ch = lane & 7;
#pragma unroll
    for (int j = 0; j < 4; ++j) { const int n = (lane >> 3) + 8 * j; const LAS float* s = scr + (8 * ch) * 33 + n;
        u32x4 o; o.x = pk2(s[0 * 33], s[1 * 33]); o.y = pk2(s[2 * 33], s[3 * 33]); o.z = pk2(s[4 * 33], s[5 * 33]); o.w = pk2(s[6 * 33], s[7 * 33]);
        *(u32x4*)(WT + (size_t)(n0d + n) * K + k0 + 8 * ch) = o; }
    LDS_WAIT();
}
struct ItemIt {
    unsigned* q; int n, ngw, lane, ch, cur, lim;
    DI ItemIt(unsigned* q_, int n_, int gw, int ngw_, int lane_, int ch_) : q(q_), n(n_), ngw(ngw_), lane(lane_), ch(ch_), cur(q_ ? 0 : gw - ngw_), lim(0) {}
    DI bool next(int& it) {
        if (!q) { cur += ngw; it = cur; return cur < n; }
        if (cur >= lim) { unsigned b = 0; if (lane == 0) b = atomicAdd(q, (unsigned)ch); cur = (int)__builtin_amdgcn_readfirstlane(b); lim = cur + ch; }
        it = cur++; return it < n;
    }
};
DI void tr_item_s(const float* W, int Ktot, int Nsrc, bf16_t* WT, int ldd, int ks0, int kd0, int n0d, int n0s, LAS float* scr, int lane) {
    const int c = lane & 31;
#pragma unroll
    for (int i = 0; i < 32; ++i) { const int kk = 2 * i + (lane >> 5); scr[kk * 33 + c] = (ks0 + kk < Ktot) ? W[(size_t)(ks0 + kk) * Nsrc + n0s + c] : 0.f; }
    LDS_WAIT();
    const int ch = lane & 7;
#pragma unroll
    for (int j = 0; j < 4; ++j) { const int n = (lane >> 3) + 8 * j; const LAS float* sp = scr + (8 * ch) * 33 + n;
        u32x4 o; o.x = pk2(sp[0 * 33], sp[1 * 33]); o.y = pk2(sp[2 * 33], sp[3 * 33]); o.z = pk2(sp[4 * 33], sp[5 * 33]); o.w = pk2(sp[6 * 33], sp[7 * 33]);
        *(u32x4*)(WT + (size_t)(n0d + n) * ldd + kd0 + 8 * ch) = o; }
    LDS_WAIT();
}
DI void conv_slice_item(const Args& a, int which, int it, LAS float* scr, int lane) {
    const float* Wd = a.in[which ? I_F2D : I_F1D]; bf16_t* BS = (bf16_t*)(a.ws + WS_BS);
    const int sl = it / (22 * 64), r = it % (22 * 64), kb = r / 64, gi = r % 64;
    tr_item_s(Wd, FF, 2048, BS, KS, sl * KS + kb * 64, kb * 64, sl * 2048 + gi * 32, gi * 32, scr, lane);
}
DI void conv_ffn_item(const Args& a, int which, int it, LAS float* scr, int lane) {
    constexpr int IT_GU = 32 * 344;
    if (it < IT_GU) { const int kb = it / 344, gi = it % 344, n0d = gi * 32, pn = n0d >> 8, half = (n0d >> 7) & 1, idx = n0d & 127;
        tr_item(a.in[half ? (which ? I_F2U : I_F1U) : (which ? I_F2G : I_F1G)], 2048, FF, (bf16_t*)(a.ws + WS_WGU), kb * 64, n0d, pn * 128 + idx, 32, scr, lane); }
    else { const int r = it - IT_GU, kb = r / 64, gi = r % 64; tr_item(a.in[which ? I_F2D : I_F1D], FF, 2048, (bf16_t*)(a.ws + WS_WD), kb * 64, gi * 32, gi * 32, 32, scr, lane); }
}
DI void conv_ffn2_range(const Args& a, LAS unsigned char* lds, int lo, int hi, int gw, int ngw, int wave, int lane, unsigned* q) {
    LAS float* scr = (LAS float*)(lds + wave * 8704);
    int it; for (ItemIt ii(q, hi - lo, gw, ngw, lane, 4); ii.next(it); ) { const int u = lo + it; if (u < 16512) conv_ffn_item(a, 1, u, scr, lane); else conv_slice_item(a, 1, u - 16512, scr, lane); }
}
DI void conv_down_slices(const Args& a, LAS unsigned char* lds, int which, int gw, int ngw, int wave, int lane, unsigned* q = nullptr) {
    LAS float* scr = (LAS float*)(lds + wave * 8704);
    const float* Wd = a.in[which ? I_F2D : I_F1D]; bf16_t* BS = (bf16_t*)(a.ws + WS_BS);
    int it; for (ItemIt ii(q, NSL * 22 * 64, gw, ngw, lane, 4); ii.next(it); ) { const int sl = it / (22 * 64), r = it % (22 * 64), kb = r / 64, gi = r % 64;
        tr_item_s(Wd, FF, 2048, BS, KS, sl * KS + kb * 64, kb * 64, sl * 2048 + gi * 32, gi * 32, scr, lane); }
}
DI void conv_ffn(const Args& a, LAS unsigned char* lds, int which  , int gw, int ngw, int wave, int lane, unsigned* q = nullptr) {
    LAS float* scr = (LAS float*)(lds + wave * 8704);
    const float* Wg = a.in[which ? I_F2G : I_F1G]; const float* Wu = a.in[which ? I_F2U : I_F1U]; const float* Wd = a.in[which ? I_F2D : I_F1D];
    bf16_t* WGU = (bf16_t*)(a.ws + WS_WGU); bf16_t* WD = (bf16_t*)(a.ws + WS_WD);
    constexpr int IT_GU = 32 * 344, IT_D = 86 * 64;
    int it; for (ItemIt ii(q, IT_GU + IT_D, gw, ngw, lane, 4); ii.next(it); ) {
        if (it < IT_GU) { const int kb = it / 344, gi = it % 344, n0d = gi * 32, pn = n0d >> 8, half = (n0d >> 7) & 1, idx = n0d & 127;
            tr_item(half ? Wu : Wg, 2048, FF, WGU, kb * 64, n0d, pn * 128 + idx, 32, scr, lane); }
        else { const int r = it - IT_GU, kb = r / 64, gi = r % 64; tr_item(Wd, FF, 2048, WD, kb * 64, gi * 32, gi * 32, 32, scr, lane); }
    }
}
DI void conv_rest(const Args& a, LAS unsigned char* lds, int gw, int ngw, int wave, int lane, unsigned* q = nullptr) {
    LAS float* scr = (LAS float*)(lds + wave * 8704);
    constexpr int IT_IN = 32 * 240, IT_GATE = 32 * 128, IT_BR = 16 * 64, IT_OUT = 32 * 64;
    int it; for (ItemIt ii(q, IT_IN + IT_GATE + 2 * IT_BR + IT_OUT, gw, ngw, lane, 4); ii.next(it); ) {
        int r = it;
        if (r < IT_IN) { const int kb = r / 240, gi = r % 240, n0d = gi * 32; int n0s, nv;
            if (gi < 105) { n0s = n0d; nv = 32; } else if (gi == 105) { n0s = 7456; nv = 8; } else if (gi < 112) { n0s = 0; nv = 0; } else { n0s = 3360 + (n0d - 3584); nv = 32; }
            tr_item(a.in[I_WIN], 2048, 11560, (bf16_t*)(a.ws + WS_WIN), kb * 64, n0d, n0s, nv, scr, lane); continue; }
        r -= IT_IN;
        if (r < IT_GATE) { const int kb = r / 128, gi = r % 128; tr_item(a.in[I_WIN], 2048, 11560, (bf16_t*)(a.ws + WS_WGATE), kb * 64, gi * 32, 7464 + gi * 32, 32, scr, lane); continue; }
        r -= IT_GATE;
        if (r < IT_BR) { const int kb = r / 64, gi = r % 64; tr_item(a.in[I_BRRW], 1024, 2048, (bf16_t*)(a.ws + WS_WBRRW), kb * 64, gi * 32, gi * 32, 32, scr, lane); continue; }
        r -= IT_BR;
        if (r < IT_BR) { const int kb = r / 64, gi = r % 64; tr_item(a.in[I_BRML], 1024, 2048, (bf16_t*)(a.ws + WS_WBRML), kb * 64, gi * 32, gi * 32, 32, scr, lane); continue; }
        r -= IT_BR;
        { const int kb = r / 64, gi = r % 64; tr_item(a.in[I_WOUT], 2048, 2048, (bf16_t*)(a.ws + WS_WOUT), kb * 64, gi * 32, gi * 32, 32, scr, lane); }
    }
}
DI void rms_row2_bf16(const float* xa, const float* xb, const float* g, bf16_t* oa, bf16_t* ob, int lane) {
    f32x4 va[8], vb[8]; float sa = 0.f, sb = 0.f;
#pragma unroll
    for (int j = 0; j < 8; ++j) { va[j] = ((const f32x4*)xa)[lane + 64 * j]; vb[j] = ((const f32x4*)xb)[lane + 64 * j]; }
#pragma unroll
    for (int j = 0; j < 8; ++j) { sa += (va[j].x * va[j].x + va[j].y * va[j].y) + (va[j].z * va[j].z + va[j].w * va[j].w); sb += (vb[j].x * vb[j].x + vb[j].y * vb[j].y) + (vb[j].z * vb[j].z + vb[j].w * vb[j].w); }
    const float ra = rsqrtf(wave_sum(sa) * (1.f / D) + 1e-6f), rb = rsqrtf(wave_sum(sb) * (1.f / D) + 1e-6f);
#pragma unroll
    for (int j = 0; j < 8; ++j) { const f32x4 gg = ((const f32x4*)g)[lane + 64 * j];
        u32x2 o; o.x = pk2(va[j].x * ra * gg.x, va[j].y * ra * gg.y); o.y = pk2(va[j].z * ra * gg.z, va[j].w * ra * gg.w); ((u32x2*)oa)[lane + 64 * j] = o;
        u32x2 p; p.x = pk2(vb[j].x * rb * gg.x, vb[j].y * rb * gg.y); p.y = pk2(vb[j].z * rb * gg.z, vb[j].w * rb * gg.w); ((u32x2*)ob)[lane + 64 * j] = p; }
}
DI void rms_row_bf16(const float* xr, const float* g, bf16_t* orow, int lane) {
    f32x4 v[8]; float s = 0.f;
#pragma unroll
    for (int j = 0; j < 8; ++j) { v[j] = ((const f32x4*)xr)[lane + 64 * j]; s += (v[j].x * v[j].x + v[j].y * v[j].y) + (v[j].z * v[j].z + v[j].w * v[j].w); }
    const float r = rsqrtf(wave_sum(s) * (1.f / D) + 1e-6f);
#pragma unroll
    for (int j = 0; j < 8; ++j) { const f32x4 gg = ((const f32x4*)g)[lane + 64 * j]; u32x2 o; o.x = pk2(v[j].x * r * gg.x, v[j].y * r * gg.y); o.y = pk2(v[j].z * r * gg.z, v[j].w * r * gg.w);
        ((u32x2*)orow)[lane + 64 * j] = o; }
}
DI void rms_row2_f32(float* xa, float* xb, const float* g, int lane) {
    f32x4 va[8], vb[8]; float sa = 0.f, sb = 0.f;
#pragma unroll
    for (int j = 0; j < 8; ++j) { va[j] = ((const f32x4*)xa)[lane + 64 * j]; vb[j] = ((const f32x4*)xb)[lane + 64 * j]; }
#pragma unroll
    for (int j = 0; j < 8; ++j) { sa += (va[j].x * va[j].x + va[j].y * va[j].y) + (va[j].z * va[j].z + va[j].w * va[j].w); sb += (vb[j].x * vb[j].x + vb[j].y * vb[j].y) + (vb[j].z * vb[j].z + vb[j].w * vb[j].w); }
    const float ra = rsqrtf(wave_sum(sa) * (1.f / D) + 1e-6f) * DBG_SY, rb = rsqrtf(wave_sum(sb) * (1.f / D) + 1e-6f) * DBG_SY;
#pragma unroll
    for (int j = 0; j < 8; ++j) { const f32x4 gg = ((const f32x4*)g)[lane + 64 * j]; ((f32x4*)xa)[lane + 64 * j] = va[j] * ra * gg; ((f32x4*)xb)[lane + 64 * j] = vb[j] * rb * gg; }
}
DI void rms_row_f32(float* xr, const float* g, int lane, float dbg = 1.f) {
    f32x4 v[8]; float s = 0.f;
#pragma unroll
    for (int j = 0; j < 8; ++j) { v[j] = ((const f32x4*)xr)[lane + 64 * j]; s += (v[j].x * v[j].x + v[j].y * v[j].y) + (v[j].z * v[j].z + v[j].w * v[j].w); }
    const float r = rsqrtf(wave_sum(s) * (1.f / D) + 1e-6f);
#pragma unroll
    for (int j = 0; j < 8; ++j) { const f32x4 gg = ((const f32x4*)g)[lane + 64 * j]; ((f32x4*)xr)[lane + 64 * j] = v[j] * (r * DBG_SY * dbg) * gg; }
}
DI int seq_row(int kind, int b, int t) { return kind ? (NPR + b * 16 + t) : (t < 16 ? NREAL + t : b * 4096 + t - 16); }
typedef float f32p __attribute__((ext_vector_type(2)));
DI void rwkv_task(const Args& a, LAS unsigned char* lds, int kind, int b, int h) {
    int tid_ = threadIdx.x; asm volatile("" : "+v"(tid_));
    const int tid = tid_, wave = tid >> 6, lane = tid & 63, fr = lane & 15, fq = lane >> 4;
    constexpr int BUFB = 57856;
    constexpr int OW = 0, OA = 2048, OB = 4096, OK = 6144, OR = 8192, OV = 10240, OG = 12288, OBON = 14336;
    LAS float* Yall = (LAS float*)(lds + 2 * BUFB);
    LAS bf16_t* Atl = (LAS bf16_t*)(lds + 2 * BUFB + 16384);
    const bf16_t* P = (const bf16_t*)(a.ws + WS_P);
    const bf16_t* w2T = (const bf16_t*)(a.ws + WS_W2T); const bf16_t* a2T = (const bf16_t*)(a.ws + WS_A2T); const bf16_t* g2T = (const bf16_t*)(a.ws + WS_G2T);
    bf16_t* YRW = (bf16_t*)(a.ws + WS_YRW);
    const int T = kind ? 16 : 4112, NC = kind ? 1 : 129;
    const int pw = wave - 4;
    const int ep = lane & 15, ec = ep * 4, ehc = h * 64 + ec;
    const int gcol = lane < 24 ? (lane >> 3) * 1024 + h * 64 + (lane & 7) * 8 : 3072 + ((lane < 60 ? lane : 59) - 24) * 8;
    float mu8[8];
#pragma unroll
    for (int q = 0; q < 8; ++q) mu8[q] = a.in[I_MU][gcol + q];
    const f32x4 w0 = *(const f32x4*)(a.in[I_W0] + ehc), a0 = *(const f32x4*)(a.in[I_A0] + ehc), kkw = *(const f32x4*)(a.in[I_KK] + ehc), kaw = *(const f32x4*)(a.in[I_KA] + ehc),
                rk = *(const f32x4*)(a.in[I_RK] + ehc), lw = *(const f32x4*)(a.in[I_LNW] + ehc), lb = *(const f32x4*)(a.in[I_LNB] + ehc);
    u32x4 raw[9];
    auto issue = [&](int c) {
        const int t0 = c ? 16 + 32 * (c - 1) : 0, Lc = c ? 32 : 16;
        if (pw * 8 >= Lc || lane >= 60) return;
        const int tb = t0 + pw * 8;
#pragma unroll
        for (int q = 0; q < 9; ++q) { const int t = tb - 1 + q; raw[q] = (t >= 0) ? *(const u32x4*)(P + (size_t)seq_row(kind, b, t) * PLD + gcol) : (u32x4){0u, 0u, 0u, 0u}; }
    };
    auto prep = [&](int c) {
        const int t0 = c ? 16 + 32 * (c - 1) : 0, Lc = c ? 32 : 16;
        if (pw * 8 >= Lc) return;
        LAS float* Bf = (LAS float*)(lds + (c & 1) * BUFB);
        LAS bf16_t* Alw = Atl + pw * 2560; LAS bf16_t* Ala = Alw + 8 * 72; LAS bf16_t* Alg = Ala + 8 * 72;
        {
            const int tb = t0 + pw * 8;
            if (lane < 60) {
                float prev[8];
                if (tb > 0 || !kind) unpack8(raw[0], prev);
                else { const float* sp = a.in[I_SSHIFT] + (size_t)b * 3360 + gcol;
#pragma unroll
                    for (int q = 0; q < 8; ++q) prev[q] = sp[q]; }
#pragma unroll
                for (int jl = 0; jl < 8; ++jl) {
                    const int j = pw * 8 + jl;
                    float cur[8], u[8];
                    unpack8(raw[jl + 1], cur);
#pragma unroll
                    for (int q = 0; q < 8; ++q) { u[q] = cur[q] + mu8[q] * (prev[q] - cur[q]); prev[q] = cur[q]; }
                    if (lane < 24) { LAS float* dst = Bf + (lane < 8 ? OR : (lane < 16 ? OK : OV)) + j * 64 + (lane & 7) * 8;
                        *(LAS f32x4*)dst = (f32x4){u[0], u[1], u[2], u[3]}; *(LAS f32x4*)(dst + 4) = (f32x4){u[4], u[5], u[6], u[7]}; }
                    else {
                        LAS bf16_t* dst = lane < 32 ? Alw + jl * 72 + (lane - 24) * 8 : (lane < 40 ? Ala + jl * 72 + (lane - 32) * 8 : Alg + jl * 168 + (lane - 40) * 8);
                        u32x4 w; w.x = pk2(u[0], u[1]); w.y = pk2(u[2], u[3]); w.z = pk2(u[4], u[5]); w.w = pk2(u[6], u[7]);
                        *(LAS u32x4*)dst = w;
                    }
                }
            }
        }
        LDS_WAIT();
#pragma unroll
        for (int i = 0; i < 4; ++i) {
            const int idx = lane + 64 * i;
            if (idx < 224) {
                const bool isw = idx < 64; const int r2 = idx - 64;
                LAS bf16_t* p = isw ? Alw + (idx >> 3) * 72 + (idx & 7) * 8 : Alg + (r2 / 20) * 168 + (r2 % 20) * 8;
                const float al = isw ? 2.f : 1.f, be = isw ? 1.f : 0.f;
                float x[8]; unpack8(*(const LAS u32x4*)p, x);
#pragma unroll
                for (int q = 0; q < 8; ++q) x[q] = al * sigm(al * x[q]) - be;
                u32x4 w; w.x = pk2(x[0], x[1]); w.y = pk2(x[2], x[3]); w.z = pk2(x[4], x[5]); w.w = pk2(x[6], x[7]);
                *(LAS u32x4*)p = w;
            }
        }
        LDS_WAIT();
        {
            const int arow = fr & 7;
            bf16x8 Bc[9], Bn[9];
            auto ldB = [&](bf16x8 (&Bx)[9], int tc) { const int bcol = h * 64 + tc * 16 + fr;
#pragma unroll
                for (int ks = 0; ks < 2; ++ks) { Bx[ks] = *(const bf16x8*)(w2T + (size_t)bcol * 64 + ks * 32 + fq * 8); Bx[2 + ks] = *(const bf16x8*)(a2T + (size_t)bcol * 64 + ks * 32 + fq * 8); }
#pragma unroll
                for (int ks = 0; ks < 5; ++ks) Bx[4 + ks] = *(const bf16x8*)(g2T + (size_t)bcol * 160 + ks * 32 + fq * 8); };
            ldB(Bc, 0);
#pragma unroll
            for (int tc = 0; tc < 4; ++tc) {
                if (tc < 3) ldB(Bn, tc + 1);
                f32x4 zw = {0.f, 0.f, 0.f, 0.f}, za = zw, zg = zw;
#pragma unroll
                for (int ks = 0; ks < 2; ++ks) { zw = __builtin_amdgcn_mfma_f32_16x16x32_bf16(*(const LAS bf16x8*)(Alw + arow * 72 + ks * 32 + fq * 8), Bc[ks], zw, 0, 0, 0);
                    za = __builtin_amdgcn_mfma_f32_16x16x32_bf16(*(const LAS bf16x8*)(Ala + arow * 72 + ks * 32 + fq * 8), Bc[2 + ks], za, 0, 0, 0); }
#pragma unroll
                for (int ks = 0; ks < 5; ++ks) zg = __builtin_amdgcn_mfma_f32_16x16x32_bf16(*(const LAS bf16x8*)(Alg + arow * 168 + ks * 32 + fq * 8), Bc[4 + ks], zg, 0, 0, 0);
                asm volatile("" ::: "memory");
                if (fq < 2) {
#pragma unroll
                    for (int q = 0; q < 4; ++q) { const int o = (pw * 8 + fq * 4 + q) * 64 + tc * 16 + fr; Bf[OW + o] = zw[q]; Bf[OA + o] = za[q]; Bf[OG + o] = zg[q]; }
                }
#pragma unroll
                for (int q = 0; q < 9; ++q) Bc[q] = Bn[q];
            }
        }
        LDS_WAIT();
#pragma unroll
        for (int i = 0; i < 2; ++i) {
            const int j = pw * 8 + (lane >> 4) + 4 * i, o = j * 64 + ec;
            const f32x4 zw = *(LAS f32x4*)(Bf + OW + o), za = *(LAS f32x4*)(Bf + OA + o), uk = *(LAS f32x4*)(Bf + OK + o), ur = *(LAS f32x4*)(Bf + OR + o);
            f32x4 dec, av, kkv, kp; float ss = 0.f, bd = 0.f;
#pragma unroll
            for (int q = 0; q < 4; ++q) {
                const float e = sigm(zw[q] + w0[q]) * 0.60653066f;
                dec[q] = __expf(-e);
                av[q] = sigm(a0[q] + za[q]);
                kkv[q] = uk[q] * kkw[q]; ss += kkv[q] * kkv[q];
                kp[q] = uk[q] * (1.f + (av[q] - 1.f) * kaw[q]);
                bd += ur[q] * kp[q] * rk[q];
            }
            ss = sum16(ss); bd = sum16(bd);
            const float inv = 1.f / fmaxf(sqrtf(ss), 1e-12f);
            f32x4 na, nb;
#pragma unroll
            for (int q = 0; q < 4; ++q) { const float kk = kkv[q] * inv; na[q] = -kk; nb[q] = kk * av[q]; }
            *(LAS f32x4*)(Bf + OW + o) = dec; *(LAS f32x4*)(Bf + OA + o) = na; *(LAS f32x4*)(Bf + OB + o) = nb; *(LAS f32x4*)(Bf + OK + o) = kp;
            if (ep == 0) Bf[OBON + j] = bd;
        }
        LDS_WAIT();
    };
    auto outp = [&](int c) {
        const int t0 = c ? 16 + 32 * (c - 1) : 0, Lc = c ? 32 : 16;
        if (pw * 8 >= Lc) return;
        LAS float* Bf = (LAS float*)(lds + (c & 1) * BUFB); LAS float* Yv = Yall + (c & 1) * 2048;
#pragma unroll
        for (int i = 0; i < 2; ++i) {
            const int j = pw * 8 + (lane >> 4) + 4 * i, o = j * 64 + ec;
            const int row = seq_row(kind, b, t0 + j);
            const f32x4 y = *(LAS f32x4*)(Yv + o), vv = *(LAS f32x4*)(Bf + OV + o), gg = *(LAS f32x4*)(Bf + OG + o);
            const float mean = sum16((y[0] + y[1]) + (y[2] + y[3])) * (1.f / 64.f);
            const f32x4 d = y - mean;
            const float var = sum16((d[0] * d[0] + d[1] * d[1]) + (d[2] * d[2] + d[3] * d[3])) * (1.f / 64.f);
            const float rs = rsqrtf(var + 64e-5f), bo = Bf[OBON + j];
            if (row < NREAL) {
                f32x4 o4;
#pragma unroll
                for (int q = 0; q < 4; ++q) o4[q] = (d[q] * rs * lw[q] + lb[q] + bo * vv[q]) * gg[q];
                u32x2 w; w.x = pk2(o4[0], o4[1]); w.y = pk2(o4[2], o4[3]);
                *(u32x2*)(YRW + (size_t)row * 1024 + ehc) = w;
            }
        }
        LDS_WAIT();
    };
    const int rp = (tid >> 3) & 31, kq = tid & 7;
    f32p S0[4], S1[4];
    if (kind) { const float* s0 = a.in[I_SWKV] + ((size_t)(b * 16 + h) * 64 + rp) * 64 + kq * 8; const float* s1 = s0 + 32 * 64;
#pragma unroll
        for (int i = 0; i < 4; ++i) { S0[i] = (f32p){s0[2 * i], s0[2 * i + 1]}; S1[i] = (f32p){s1[2 * i], s1[2 * i + 1]}; } }
    else {
#pragma unroll
        for (int i = 0; i < 4; ++i) { S0[i] = (f32p){0.f, 0.f}; S1[i] = (f32p){0.f, 0.f}; } }
    if (wave >= 4) { issue(0); prep(0); if (NC > 1) issue(1); }
    __syncthreads();
    for (int c = 0; c < NC; ++c) {
        if (wave < 4) {
            const int Lc = c ? 32 : 16;
            const LAS float* Bf = (const LAS float*)(lds + (c & 1) * BUFB); LAS float* Yv = Yall + (c & 1) * 2048;
#pragma unroll 2
            for (int j = 0; j < Lc; ++j) {
                const int o = j * 64 + kq * 8;
                f32p w[4], aa[4], bb[4], kk[4], rr[4];
#pragma unroll
                for (int i = 0; i < 4; ++i) { w[i] = *(const LAS f32p*)(Bf + OW + o + 2 * i); aa[i] = *(const LAS f32p*)(Bf + OA + o + 2 * i); bb[i] = *(const LAS f32p*)(Bf + OB + o + 2 * i);
                    kk[i] = *(const LAS f32p*)(Bf + OK + o + 2 * i); rr[i] = *(const LAS f32p*)(Bf + OR + o + 2 * i); }
                const float v0 = Bf[OV + j * 64 + rp], v1 = Bf[OV + j * 64 + rp + 32];
                f32p p0 = S0[0] * aa[0], p1 = S1[0] * aa[0];
#pragma unroll
                for (int i = 1; i < 4; ++i) { p0 += S0[i] * aa[i]; p1 += S1[i] * aa[i]; }
                const float sa0 = sum8(p0.x + p0.y), sa1 = sum8(p1.x + p1.y);
                const f32p sa0v = {sa0, sa0}, sa1v = {sa1, sa1}, v0v = {v0, v0}, v1v = {v1, v1};
#pragma unroll
                for (int i = 0; i < 4; ++i) { S0[i] = S0[i] * w[i] + sa0v * bb[i] + v0v * kk[i]; S1[i] = S1[i] * w[i] + sa1v * bb[i] + v1v * kk[i]; }
                f32p q0 = S0[0] * rr[0], q1 = S1[0] * rr[0];
#pragma unroll
                for (int i = 1; i < 4; ++i) { q0 += S0[i] * rr[i]; q1 += S1[i] * rr[i]; }
                const float y0 = sum8(q0.x + q0.y), y1 = sum8(q1.x + q1.y);
                if (kq == 0) { Yv[j * 64 + rp] = y0; Yv[j * 64 + rp + 32] = y1; }
            }
        } else {
            if (c >= 1) outp(c - 1);
            if (c + 1 < NC) prep(c + 1);
            if (c + 2 < NC) issue(c + 2);
        }
        __syncthreads();
    }
    if (wave >= 4) outp(NC - 1);
    if (wave < 4) {
        float* so = a.out + (kind ? O_SWKV : O_PWKV) + ((size_t)(b * 16 + h) * 64 + rp) * 64 + kq * 8;
        *(f32x4*)so = (f32x4){S0[0].x, S0[0].y, S0[1].x, S0[1].y} * DBG_SR; *(f32x4*)(so + 4) = (f32x4){S0[2].x, S0[2].y, S0[3].x, S0[3].y} * DBG_SR;
        so += 32 * 64;
        *(f32x4*)so = (f32x4){S1[0].x, S1[0].y, S1[1].x, S1[1].y} * DBG_SR; *(f32x4*)(so + 4) = (f32x4){S1[2].x, S1[2].y, S1[3].x, S1[3].y} * DBG_SR;
    }
    if (h == 0) {
        float* sh = a.out + (kind ? O_SSHIFT : O_PSHIFT) + (size_t)b * 3360;
        const bf16_t* pr = P + (size_t)seq_row(kind, b, T - 1) * PLD;
        for (int c = tid; c < 3360; c += 512) sh[c] = __uint_as_float((unsigned)pr[c] << 16);
    }
    __syncthreads();
}
DI int off512(int row, int chunk) { return row * 512 + ((chunk ^ (row & 15)) << 4); }
DI int off128(int row, int chunk) { return row * 128 + ((chunk ^ ((row >> 1) & 7)) << 4); }
DI u32x4 ml_qk_row(const Args& a, const bf16_t* P, int kind, int b, int T, int tg, int chan) {
    u32x4 z = {0u, 0u, 0u, 0u};
    if (tg >= T) return z;
    if (tg < 0) {
        if (!kind) return z;
        const float* sp = a.in[I_SCONV] + ((size_t)b * 3 + (3 + tg)) * 2048 + chan;
        u32x4 w; w.x = pk2(sp[0], sp[1]); w.y = pk2(sp[2], sp[3]); w.z = pk2(sp[4], sp[5]); w.w = pk2(sp[6], sp[7]); return w;
    }
    return *(const u32x4*)(P + (size_t)seq_row(kind, b, tg) * PLD + P_QK + chan);
}
DI void mlstm_task(const Args& a, LAS unsigned char* lds, int kind, int b, int head, int vs) {
    int tid_ = threadIdx.x; asm volatile("" : "+v"(tid_));
    const int tid = tid_, wave = tid >> 6, lane = tid & 63, fr_ = lane & 15, fq_ = lane >> 4;
    LAS unsigned char* qs = lds; LAS unsigned char* ks = lds + 32768; LAS unsigned char* kT = lds + 65536; LAS unsigned char* vT = lds + 98304;
    LAS unsigned char* CbT = lds + 106496; LAS unsigned char* sP = lds + 139264;
    LAS float* nS = (LAS float*)(lds + 147456); LAS float* sc_c = nS + 256; LAS float* sc_M = sc_c + 64; LAS float* sc_win = sc_M + 64; LAS float* sc_enmq = sc_win + 64;
    LAS float* sc_wk = sc_enmq + 64; LAS float* denp = sc_wk + 64; LAS float* dinvS = denp + 128; LAS float* misc = dinvS + 64;
    const bf16_t* P = (const bf16_t*)(a.ws + WS_P); const float* IFp = (const float*)(a.ws + WS_IF); bf16_t* HM = (bf16_t*)(a.ws + WS_YML);
    const int T = kind ? 16 : 4112;
    const float ib = a.in[I_IB][head], fb = a.in[I_FB][head];
    f32x4 Cacc[2][4];
    {
        const int fr = fr_, fq = fq_;
        const float* C0 = a.in[I_SC] + (size_t)(b * 4 + head) * 65536 + vs * 64;
#pragma unroll
        for (int k2 = 0; k2 < 2; ++k2)
#pragma unroll
            for (int vt = 0; vt < 4; ++vt)
#pragma unroll
                for (int j = 0; j < 4; ++j) { const int key = (wave * 2 + k2) * 16 + fq * 4 + j, v = vt * 16 + fr; Cacc[k2][vt][j] = kind ? C0[(size_t)key * 256 + v] : 0.f; }
#pragma unroll
        for (int k2 = 0; k2 < 2; ++k2)
#pragma unroll
            for (int vt = 0; vt < 4; ++vt) { const int key0 = (wave * 2 + k2) * 16 + fq * 4, v = vt * 16 + fr; u32x2 w; w.x = pk2(Cacc[k2][vt][0], Cacc[k2][vt][1]); w.y = pk2(Cacc[k2][vt][2], Cacc[k2][vt][3]);
                *(LAS u32x2*)(CbT + off512(v, key0 >> 3) + (key0 & 7) * 2) = w; }
        if (tid < 256) nS[tid] = kind ? a.in[I_SN][(size_t)(b * 4 + head) * 256 + tid] : 0.f;
    }
    float m = kind ? a.in[I_SM][b * 4 + head] : 0.f;
    float pre_i = 0.f, pre_f = 0.f;
    if (wave == 0 && lane < 16) { const int r0 = seq_row(kind, b, lane); pre_i = IFp[(size_t)r0 * 8 + head]; pre_f = IFp[(size_t)r0 * 8 + 4 + head]; }
    __syncthreads();
    for (int t0 = 0; t0 < T;) {
        const int L = (t0 == 0) ? 16 : 64;
        if (wave == 0) {
            const int t = lane; const bool valid = t < L;
            const float iv = valid ? pre_i + ib : -INFINITY;
            const float x = valid ? pre_f + fb : 0.f;
            { const int tn = t0 + L + t; if (tn < T) { const int rn = seq_row(kind, b, tn); pre_i = IFp[(size_t)rn * 8 + head]; pre_f = IFp[(size_t)rn * 8 + 4 + head]; } }
            const float lf = valid ? (fminf(x, 0.f) - log1pf(__expf(-fabsf(x)))) : 0.f;
            float bs = lf;
#pragma unroll
            for (int o = 1; o < 64; o <<= 1) { const float y = __shfl_up(bs, o); if (lane >= o) bs += y; }
            const float c = iv - bs;
            float pm = c;
#pragma unroll
            for (int o = 1; o < 64; o <<= 1) { const float y = __shfl_up(pm, o); if (lane >= o) pm = fmaxf(pm, y); }
            const float M = fmaxf(m, pm);
            const float M63 = __shfl(M, 63), b63 = __shfl(bs, 63);
            sc_c[t] = c; sc_M[t] = M; sc_win[t] = __expf(m - M); sc_enmq[t] = __expf(-(bs + M)); sc_wk[t] = __expf(c - M63);
            if (lane == 0) { misc[0] = __expf(m - M63); misc[1] = b63 + M63; }
        }
        __syncthreads();
#ifndef NO_B
        {
            const int cgp = tid & 63, pg = wave; const bool isk = cgp >= 32; const int kc = cgp & 31;
            const int chan = (isk ? 1024 : 0) + head * 256 + kc * 8;
            const int pos = tid >> 3, c8 = tid & 7;
            u32x4 vv = {0u, 0u, 0u, 0u};
            if (pos < L) vv = *(const u32x4*)(P + (size_t)seq_row(kind, b, t0 + pos) * PLD + P_V + head * 256 + vs * 64 + c8 * 8);
            float cw[4][8], cb[8];
#pragma unroll
            for (int j = 0; j < 4; ++j)
#pragma unroll
                for (int i = 0; i < 8; ++i) cw[j][i] = a.in[I_CW][j * 2048 + chan + i];
#pragma unroll
            for (int i = 0; i < 8; ++i) cb[i] = a.in[I_CB][chan + i];
            u32x4 raw[11];
#pragma unroll
            for (int q = 0; q < 11; ++q) raw[q] = ml_qk_row(a, P, kind, b, T, t0 + pg * 8 - 3 + q, chan);
            float x0[8], x1[8], x2[8];
            unpack8(raw[0], x0); unpack8(raw[1], x1); unpack8(raw[2], x2);
#pragma unroll
            for (int p = 0; p < 8; ++p) {
                const int tt = pg * 8 + p;
                float o[8], x3[8];
                unpack8(raw[p + 3], x3);
#pragma unroll
                for (int i = 0; i < 8; ++i) { float s = cb[i] + cw[0][i] * x0[i] + cw[1][i] * x1[i] + cw[2][i] * x2[i] + cw[3][i] * x3[i]; s = s * sigm(s); if (isk) s *= 0.0625f; o[i] = (tt < L) ? s : 0.f; }
                u32x4 w; w.x = pk2(o[0], o[1]); w.y = pk2(o[2], o[3]); w.z = pk2(o[4], o[5]); w.w = pk2(o[6], o[7]);
                *(LAS u32x4*)((isk ? ks : qs) + off512(tt, kc)) = w;
                if (isk) {
                    const float wkp = sc_wk[tt];
#pragma unroll
                    for (int i = 0; i < 8; ++i) *(LAS unsigned short*)(kT + off128(kc * 8 + i, pg) + p * 2) = (unsigned short)(pk2(o[i] * wkp, 0.f) & 0xffffu);
                }
#pragma unroll
                for (int i = 0; i < 8; ++i) { x0[i] = x1[i]; x1[i] = x2[i]; x2[i] = x3[i]; }
            }
            const unsigned vw[4] = {vv.x, vv.y, vv.z, vv.w};
#pragma unroll
            for (int i = 0; i < 8; ++i) { const int v = c8 * 8 + i; const unsigned short hv = (unsigned short)((i & 1) ? (vw[i >> 1] >> 16) : (vw[i >> 1] & 0xffffu));
                *(LAS unsigned short*)(vT + off128(v, pos >> 3) + (pos & 7) * 2) = hv; }
        }
#endif
        __syncthreads();
        {
            int fr = fr_, fq = fq_; asm volatile("" : "+v"(fr), "+v"(fq));
            const int tt_ = wave >> 1; const int t = tt_ * 16 + fr; const float Mt = sc_M[t];
            float rowsum = 0.f;
#pragma unroll
            for (int si = 0; si < 2; ++si) {
                const int st = (wave & 1) * 2 + si, s0 = st * 16 + fq * 4;
                u32x2 w = {0u, 0u};
                if (st <= tt_) {
                    f32x4 acc = {0.f, 0.f, 0.f, 0.f};
#pragma unroll
                    for (int kk = 0; kk < 8; ++kk) { const int ch = kk * 4 + fq;
                        const bf16x8 A = *(const LAS bf16x8*)(ks + off512(st * 16 + fr, ch)), B = *(const LAS bf16x8*)(qs + off512(t, ch));
                        acc = __builtin_amdgcn_mfma_f32_16x16x32_bf16(A, B, acc, 0, 0, 0); }
                    const f32x4 cs = *(const LAS f32x4*)(sc_c + s0);
                    float val[4];
#pragma unroll
                    for (int j = 0; j < 4; ++j) { val[j] = (s0 + j <= t) ? acc[j] * __expf(cs[j] - Mt) : 0.f; rowsum += val[j]; }
                    w.x = pk2(val[0], val[1]); w.y = pk2(val[2], val[3]);
                }
                *(LAS u32x2*)(sP + off128(t, s0 >> 3) + (s0 & 7) * 2) = w;
            }
            rowsum += __shfl_xor(rowsum, 16); rowsum += __shfl_xor(rowsum, 32);
            if (fq == 0) denp[(wave & 1) * 64 + t] = rowsum;
        }
        __syncthreads();
        {
            int tidx = tid; asm volatile("" : "+v"(tidx));
            const int t = tidx >> 3, part = tidx & 7; float qn = 0.f;
#pragma unroll
            for (int i = 0; i < 4; ++i) { const int c4 = part * 4 + i; float q8[8]; unpack8(*(const LAS u32x4*)(qs + off512(t, c4)), q8);
                const f32x4 n0 = *(const LAS f32x4*)(nS + c4 * 8), n1 = *(const LAS f32x4*)(nS + c4 * 8 + 4);
                qn += (q8[0] * n0[0] + q8[1] * n0[1]) + (q8[2] * n0[2] + q8[3] * n0[3]) + (q8[4] * n1[0] + q8[5] * n1[1]) + (q8[6] * n1[2] + q8[7] * n1[3]); }
            qn = sum8(qn);
            const float den = sc_win[t] * qn + denp[t] + denp[64 + t];
            if (part == 0) dinvS[t] = 1.f / fmaxf(fabsf(den), sc_enmq[t]);
        }
        __syncthreads();
        {
            int fr = fr_, fq = fq_; asm volatile("" : "+v"(fr), "+v"(fq));
            const int tt_ = wave >> 1; const int t = tt_ * 16 + fr;
            f32x4 a1[2], a2[2];
#pragma unroll
            for (int vi = 0; vi < 2; ++vi) { a1[vi] = (f32x4){0.f, 0.f, 0.f, 0.f}; a2[vi] = a1[vi]; }
#pragma unroll
            for (int kk = 0; kk < 8; ++kk) { const int ch = kk * 4 + fq; const bf16x8 B = *(const LAS bf16x8*)(qs + off512(t, ch));
#pragma unroll
                for (int vi = 0; vi < 2; ++vi) { const int vt = (wave & 1) * 2 + vi; const bf16x8 A = *(const LAS bf16x8*)(CbT + off512(vt * 16 + fr, ch)); a1[vi] = __builtin_amdgcn_mfma_f32_16x16x32_bf16(A, B, a1[vi], 0, 0, 0); } }
#pragma unroll
            for (int kk = 0; kk < 2; ++kk) { const int ch = kk * 4 + fq; const bf16x8 B = *(const LAS bf16x8*)(sP + off128(t, ch));
#pragma unroll
                for (int vi = 0; vi < 2; ++vi) { const int vt = (wave & 1) * 2 + vi; const bf16x8 A = *(const LAS bf16x8*)(vT + off128(vt * 16 + fr, ch)); a2[vi] = __builtin_amdgcn_mfma_f32_16x16x32_bf16(A, B, a2[vi], 0, 0, 0); } }
            if (t < L) {
                const int row = seq_row(kind, b, t0 + t);
                if (row < NREAL) {
                    const float win = sc_win[t], di = dinvS[t];
#pragma unroll
                    for (int vi = 0; vi < 2; ++vi) { const int vt = (wave & 1) * 2 + vi; u32x2 w;
                        w.x = pk2((win * a1[vi][0] + a2[vi][0]) * di, (win * a1[vi][1] + a2[vi][1]) * di); w.y = pk2((win * a1[vi][2] + a2[vi][2]) * di, (win * a1[vi][3] + a2[vi][3]) * di);
                        *(u32x2*)(HM + (size_t)row * 1024 + head * 256 + vs * 64 + vt * 16 + fq * 4) = w; }
                }
            }
        }
        __syncthreads();
        {
            int fr = fr_, fq = fq_, tidx = tid; asm volatile("" : "+v"(fr), "+v"(fq), "+v"(tidx));
            const float ast = misc[0], mnew = misc[1];
#pragma unroll
            for (int k2 = 0; k2 < 2; ++k2)
#pragma unroll
                for (int vt = 0; vt < 4; ++vt) Cacc[k2][vt] = Cacc[k2][vt] * ast;
#pragma unroll
            for (int kk = 0; kk < 2; ++kk) { const int ch = kk * 4 + fq;
                bf16x8 Bv[4];
#pragma unroll
                for (int vt = 0; vt < 4; ++vt) Bv[vt] = *(const LAS bf16x8*)(vT + off128(vt * 16 + fr, ch));
#pragma unroll
                for (int k2 = 0; k2 < 2; ++k2) { const bf16x8 A = *(const LAS bf16x8*)(kT + off128((wave * 2 + k2) * 16 + fr, ch));
#pragma unroll
                    for (int vt = 0; vt < 4; ++vt) Cacc[k2][vt] = __builtin_amdgcn_mfma_f32_16x16x32_bf16(A, Bv[vt], Cacc[k2][vt], 0, 0, 0); } }
#pragma unroll
            for (int k2 = 0; k2 < 2; ++k2)
#pragma unroll
                for (int vt = 0; vt < 4; ++vt) { const int key0 = (wave * 2 + k2) * 16 + fq * 4, v = vt * 16 + fr; u32x2 w; w.x = pk2(Cacc[k2][vt][0], Cacc[k2][vt][1]); w.y = pk2(Cacc[k2][vt][2], Cacc[k2][vt][3]);
                    *(LAS u32x2*)(CbT + off512(v, key0 >> 3) + (key0 & 7) * 2) = w; }
            if (tidx < 256) { float s = 0.f;
#pragma unroll
                for (int c = 0; c < 8; ++c) { float k8[8]; unpack8(*(const LAS u32x4*)(kT + off128(tidx, c)), k8); s += (k8[0] + k8[1]) + (k8[2] + k8[3]) + (k8[4] + k8[5]) + (k8[6] + k8[7]); }
                nS[tidx] = ast * nS[tidx] + s; }
            m = mnew;
        }
        __syncthreads();
        t0 += L;
    }
    {
        const int fr = fr_, fq = fq_;
        float* Co = a.out + (kind ? O_SC : O_PC) + (size_t)(b * 4 + head) * 65536 + vs * 64;
#pragma unroll
        for (int k2 = 0; k2 < 2; ++k2)
#pragma unroll
            for (int vt = 0; vt < 4; ++vt)
#pragma unroll
                for (int j = 0; j < 4; ++j) { const int key = (wave * 2 + k2) * 16 + fq * 4 + j, v = vt * 16 + fr; Co[(size_t)key * 256 + v] = Cacc[k2][vt][j] * DBG_SM; }
        if (vs == 0) {
            if (tid < 256) a.out[(kind ? O_SN : O_PN) + (size_t)(b * 4 + head) * 256 + tid] = nS[tid] * DBG_SM;
            if (tid == 0) a.out[(kind ? O_SM : O_PM) + b * 4 + head] = m * DBG_SM;
            if (head == 0) {
                float* co = a.out + (kind ? O_SCONV : O_PCONV) + (size_t)b * 3 * 2048;
                for (int i = tid; i < 3 * 2048; i += 512) { const int j = i >> 11, ch = i & 2047; co[i] = __uint_as_float((unsigned)P[(size_t)seq_row(kind, b, T - 3 + j) * PLD + P_QK + ch] << 16); }
            }
        }
    }
    __syncthreads();
}
template <class F> DI void simple_gemm(const bf16_t* A, const bf16_t* Bt, int M, int N, int K, int gw, int ngw, int lane, F&& epi) {
    const int fr = lane & 15, fq = lane >> 4, nt = N / 16;
    for (int tile = gw; tile < (M / 16) * nt; tile += ngw) {
        const int r0 = (tile / nt) * 16, c0 = (tile % nt) * 16;
        f32x4 acc = {0.f, 0.f, 0.f, 0.f};
        const bf16_t* ap = A + (size_t)(r0 + fr) * K + fq * 8; const bf16_t* bp = Bt + (size_t)(c0 + fr) * K + fq * 8;
        for (int k = 0; k < K; k += 32) { const bf16x8 a8 = *(const bf16x8*)(ap + k), b8 = *(const bf16x8*)(bp + k); acc = __builtin_amdgcn_mfma_f32_16x16x32_bf16(a8, b8, acc, 0, 0, 0); }
#pragma unroll
        for (int j = 0; j < 4; ++j) epi(r0 + fq * 4 + j, c0 + fr, acc[j]);
    }
}
#ifndef DIAG_SIMPLE
#define DIAG_SIMPLE 0
#endif
#ifndef PHMASK
#define PHMASK 0xffff
#endif
DI void gsync_own(unsigned* ctl, unsigned& epoch, unsigned G) {
    asm volatile("s_waitcnt vmcnt(0) lgkmcnt(0)" ::: "memory");
    __syncthreads();
    epoch += 1;
    if (threadIdx.x == 0) {
        __builtin_amdgcn_fence(__ATOMIC_RELEASE, "agent");
        asm volatile("s_waitcnt vmcnt(0)" ::: "memory");
        const unsigned x = blockIdx.x & 7u, nper = (G + 7u - x) >> 3, ngrp = G < 8u ? G : 8u;
        const unsigned old = __hip_atomic_fetch_add(ctl + 128 + 64 * x, 1u, __ATOMIC_RELAXED, __HIP_MEMORY_SCOPE_AGENT);
        if (old + 1u == epoch * nper) __hip_atomic_fetch_add(ctl + 64, 1u, __ATOMIC_RELAXED, __HIP_MEMORY_SCOPE_AGENT);
        while (__hip_atomic_load(ctl + 64, __ATOMIC_RELAXED, __HIP_MEMORY_SCOPE_AGENT) < epoch * ngrp) __builtin_amdgcn_s_sleep(1);
        __builtin_amdgcn_fence(__ATOMIC_ACQUIRE, "agent");
        asm volatile("s_waitcnt vmcnt(0)" ::: "memory");
    }
    __syncthreads();
}
#ifndef OWN_BARRIER
#define OWN_BARRIER 1
#endif
#if OWN_BARRIER
#define GSYNC() gsync_own((unsigned*)a.ws, epoch, (unsigned)G)
#else
#define GSYNC() grid.sync()
#endif
__global__ void __launch_bounds__(512) mk_fwd(Args a) {
    extern __shared__ __attribute__((aligned(16))) unsigned char shm[];
    LAS unsigned char* lds = (LAS unsigned char*)shm;
    cg::grid_group grid = cg::this_grid();
    const int G = (int)gridDim.x, ngw = G * 8;
    const size_t ngt = (size_t)G * 512;
#ifndef FFN2_CAP
#define FFN2_CAP 7168
#endif
#define PH_IDS int tid_ph = threadIdx.x; asm volatile("" : "+v"(tid_ph)); const int wave = tid_ph >> 6, lane = tid_ph & 63, gw = blockIdx.x * 8 + wave; const size_t gt = (size_t)blockIdx.x * 512 + tid_ph; (void)gt; (void)gw; (void)lane; (void)wave;
    bf16_t* H = (bf16_t*)(a.ws + WS_H); bf16_t* HID = (bf16_t*)(a.ws + WS_P); bf16_t* Pm = (bf16_t*)(a.ws + WS_P); bf16_t* Gt = (bf16_t*)(a.ws + WS_P);
    bf16_t* YRW = (bf16_t*)(a.ws + WS_YRW); bf16_t* YML = (bf16_t*)(a.ws + WS_YML); bf16_t* MRG = H;
    float* xinm = (float*)(a.ws + WS_XINM); float* xmeta = (float*)(a.ws + WS_XMETA); float* IFp = (float*)(a.ws + WS_IF);
    float* X = a.out;
    unsigned epoch = 0;
    grid.sync();
    if (PHMASK & 1) { PH_IDS
        for (size_t i = gt; i < 256 * 2048; i += ngt) xinm[i] = (i < 16 * 2048) ? a.in[I_META][i] : 0.f;
        bf16_t* w2T = (bf16_t*)(a.ws + WS_W2T); bf16_t* a2T = (bf16_t*)(a.ws + WS_A2T); bf16_t* g2T = (bf16_t*)(a.ws + WS_G2T);
        for (size_t i = gt; i < 1024 * 64; i += ngt) { const int n = (int)(i >> 6), k = (int)(i & 63);
            w2T[i] = (bf16_t)(pk2(a.in[I_W2][(size_t)k * 1024 + n], 0.f) & 0xffffu); a2T[i] = (bf16_t)(pk2(a.in[I_A2][(size_t)k * 1024 + n], 0.f) & 0xffffu); }
        for (size_t i = gt; i < 1024 * 160; i += ngt) { const int n = (int)(i / 160), k = (int)(i % 160); g2T[i] = (bf16_t)(pk2(a.in[I_G2][(size_t)k * 1024 + n], 0.f) & 0xffffu); }
        { bf16_t* AS = (bf16_t*)(a.ws + WS_AS);
          for (size_t i = gt; i < (size_t)TAILR * 128; i += ngt) AS[((size_t)3 * TAILR + i / 128) * KS + 1280 + (i % 128)] = 0; }
        conv_ffn(a, lds, 0, gw, ngw, wave, lane);
        conv_down_slices(a, lds, 0, gw, ngw, wave, lane);
        if ((NPR % (2 * ngw)) == 0) for (int r = gw; r < NPR; r += 2 * ngw) rms_row2_bf16(a.in[I_XP] + (size_t)r * D, a.in[I_XP] + (size_t)(r + ngw) * D, a.in[I_F1N], H + (size_t)r * D, H + (size_t)(r + ngw) * D, lane);
        for (int r = ((NPR % (2 * ngw)) == 0 ? NPR : 0) + gw; r < MA_REAL; r += ngw) {
            const float* xr = r < NPR ? a.in[I_XP] + (size_t)r * D : (r < NREAL ? a.in[I_XS] + (size_t)(r - NPR) * D : a.in[I_META] + (size_t)(r - NREAL) * D);
            rms_row_bf16(xr, a.in[I_F1N], H + (size_t)r * D, lane);
        }
    }
    GSYNC();
    if (PHMASK & 2) { EpiGU E; E.O = HID; E.AS = (bf16_t*)(a.ws + WS_AS); run_gemm(lds, H, (const bf16_t*)(a.ws + WS_WGU), MA, 11008, 2048, E);
        PH_IDS conv_rest(a, lds, gw, ngw, wave, lane, (unsigned*)a.ws + 16); }
    GSYNC();
#if DIAG_SIMPLE & 1
    simple_gemm(HID, (const bf16_t*)(a.ws + WS_WD), MA_REAL, 2048, FF, gw, ngw, lane, [&](int r, int c, float v) {
        const float* ip = r < NPR ? a.in[I_XP] + (size_t)r * D : (r < NREAL ? a.in[I_XS] + (size_t)(r - NPR) * D : xinm + (size_t)(r - NREAL) * D);
        float* op = r < NREAL ? X + (size_t)r * D : xmeta + (size_t)(r - NREAL) * D;
        op[c] = ip[c] + 0.5f * v; });
#else
    if (PHMASK & 4) { EpiDown E; E.in0 = a.in[I_XP]; E.in1 = a.in[I_XS]; E.in2 = xinm; E.o0 = X; E.o2 = xmeta; run_gemm(lds, HID, (const bf16_t*)(a.ws + WS_WD), NPR, 2048, FF, E);
        run_tail_gemm(lds, (const bf16_t*)(a.ws + WS_AS), (const bf16_t*)(a.ws + WS_BS), (float*)(a.ws + WS_PART), 3); }
#endif
    GSYNC();
    if (PHMASK & 8) { PH_IDS
        if ((NPR % (2 * ngw)) == 0) for (int r = gw; r < NPR; r += 2 * ngw) rms_row2_bf16(X + (size_t)r * D, X + (size_t)(r + ngw) * D, a.in[I_MIXN], H + (size_t)r * D, H + (size_t)(r + ngw) * D, lane);
        for (int r = ((NPR % (2 * ngw)) == 0 ? NPR : 0) + gw; r < MA_REAL; r += ngw) {
            float* xr = r < NREAL ? X + (size_t)r * D : xmeta + (size_t)(r - NREAL) * D;
            if (r >= NPR) {
                const float* xi = r < NREAL ? a.in[I_XS] + (size_t)(r - NPR) * D : a.in[I_META] + (size_t)(r - NREAL) * D;
                const float* pp = (const float*)(a.ws + WS_PART) + (size_t)(r - NPR) * D;
#pragma unroll
                for (int j = 0; j < 8; ++j) { const int e = lane + 64 * j; f32x4 v = ((const f32x4*)pp)[e];
#pragma unroll
                    for (int q = 1; q < NSL; ++q) v += ((const f32x4*)(pp + (size_t)q * TAILR * D))[e];
                    ((f32x4*)xr)[e] = ((const f32x4*)xi)[e] + 0.5f * v; }
            }
            rms_row_bf16(xr, a.in[I_MIXN], H + (size_t)r * D, lane);
        }
    }
    GSYNC();
    if (PHMASK & 16) { EpiProj E; E.O = Pm; E.IFp = IFp; run_gemm(lds, H, (const bf16_t*)(a.ws + WS_WIN), MA, PLD, 2048, E);
        PH_IDS conv_ffn2_range(a, lds, 0, FFN2_CAP, gw, ngw, wave, lane, (unsigned*)a.ws + 24); }
    GSYNC();
    if (G == 256) {
        if (blockIdx.x < 128) rwkv_task(a, lds, 0, blockIdx.x >> 4, blockIdx.x & 15);
        else {
            const int r0 = blockIdx.x - 128;
            mlstm_task(a, lds, 0, r0 >> 4, (r0 >> 2) & 3, r0 & 3);
            for (int k = 0; k < 4; ++k) { const int r = r0 + 128 * k; rwkv_task(a, lds, 1, r >> 4, r & 15); }
            for (int k = 0; k < 4; ++k) { const int r = r0 + 128 * k; mlstm_task(a, lds, 1, r >> 4, (r >> 2) & 3, r & 3); }
        }
    } else
    for (int task = blockIdx.x; task < 1280; task += G) {
#if !defined(NO_RW)
        if (task < 128) rwkv_task(a, lds, 0, task >> 4, task & 15);
        else if (task >= 256 && task < 768) { const int r = task - 256; rwkv_task(a, lds, 1, r >> 4, r & 15); }
#endif
#if !defined(NO_ML)
        if (task >= 128 && task < 256) { const int r = task - 128; mlstm_task(a, lds, 0, r >> 4, (r >> 2) & 3, r & 3); }
        else if (task >= 768) { const int r = task - 768; mlstm_task(a, lds, 1, r >> 4, (r >> 2) & 3, r & 3); }
#endif
    }
    GSYNC();
    if (PHMASK & 128) { EpiGate E; E.O = Gt; run_gemm(lds, H, (const bf16_t*)(a.ws + WS_WGATE), MC, 4096, 2048, E); }
    { PH_IDS int it; for (ItemIt ii((unsigned*)a.ws + 40, MC * 4, gw, ngw, lane, 32); ii.next(it); ) {
        const int row = it >> 2, hd = it & 3;
        bf16_t* hp = YML + (size_t)row * 1024 + hd * 256 + lane * 4;
        const u32x2 hv = *(const u32x2*)hp; const u32x2 ov = *(const u32x2*)(Pm + (size_t)row * PLD + P_O + hd * 256 + lane * 4);
        const float h0 = bf_lo(hv.x), h1 = bf_hi(hv.x), h2 = bf_lo(hv.y), h3 = bf_hi(hv.y);
        const float mean = wave_sum((h0 + h1) + (h2 + h3)) * (1.f / 256.f);
        const float d0 = h0 - mean, d1 = h1 - mean, d2 = h2 - mean, d3 = h3 - mean;
        const float var = wave_sum((d0 * d0 + d1 * d1) + (d2 * d2 + d3 * d3)) * (1.f / 256.f);
        const float rs = rsqrtf(var + 1e-5f);
        const f32x4 nw = *(const f32x4*)(a.in[I_MNW] + hd * 256 + lane * 4);
        u32x2 w; w.x = pk2(d0 * rs * nw[0] * sigm(bf_lo(ov.x)), d1 * rs * nw[1] * sigm(bf_hi(ov.x))); w.y = pk2(d2 * rs * nw[2] * sigm(bf_lo(ov.y)), d3 * rs * nw[3] * sigm(bf_hi(ov.y)));
        *(u32x2*)hp = w;
    } }
    GSYNC();
    if (PHMASK & 256) { EpiBr<true> E; E.G = Gt; E.O = MRG; E.goff = 0; run_gemm(lds, YRW, (const bf16_t*)(a.ws + WS_WBRRW), MC, 2048, 1024, E); }
    if (PHMASK & 256) { EpiBr<false> E; E.G = Gt; E.O = MRG; E.goff = 2048; run_gemm(lds, YML, (const bf16_t*)(a.ws + WS_WBRML), MC, 2048, 1024, E); }
    GSYNC();
#if DIAG_SIMPLE & 2
    simple_gemm(MRG, (const bf16_t*)(a.ws + WS_WOUT), MC, 2048, 2048, gw, ngw, lane, [&](int r, int c, float v) { X[(size_t)r * D + c] += v; });
#else
    if (PHMASK & 512) { EpiOut E; E.X = X; run_gemm(lds, MRG, (const bf16_t*)(a.ws + WS_WOUT), MC, 2048, 2048, E);
        PH_IDS conv_ffn2_range(a, lds, FFN2_CAP, 22144, gw, ngw, wave, lane, (unsigned*)a.ws + 32); }
#endif
    GSYNC();
    if (PHMASK & 1024) { PH_IDS
        if ((NPR % (2 * ngw)) == 0) for (int r = gw; r < NPR; r += 2 * ngw) rms_row2_bf16(X + (size_t)r * D, X + (size_t)(r + ngw) * D, a.in[I_F2N], H + (size_t)r * D, H + (size_t)(r + ngw) * D, lane);
        for (int r = ((NPR % (2 * ngw)) == 0 ? NPR : 0) + gw; r < MC; r += ngw) rms_row_bf16(X + (size_t)r * D, a.in[I_F2N], H + (size_t)r * D, lane); }
    GSYNC();
    if (PHMASK & 2048) { EpiGU E; E.O = HID; E.AS = (bf16_t*)(a.ws + WS_AS); run_gemm(lds, H, (const bf16_t*)(a.ws + WS_WGU), MC, 11008, 2048, E); }
    GSYNC();
#if DIAG_SIMPLE & 4
    simple_gemm(HID, (const bf16_t*)(a.ws + WS_WD), MC, 2048, FF, gw, ngw, lane, [&](int r, int c, float v) { X[(size_t)r * D + c] += 0.5f * v; });
#else
    if (PHMASK & 4096) { EpiDown E; E.in0 = X; E.in1 = X + (size_t)128 * 256 * D; E.in2 = xinm; E.o0 = X; E.o2 = xmeta; run_gemm(lds, HID, (const bf16_t*)(a.ws + WS_WD), NPR, 2048, FF, E);
        run_tail_gemm(lds, (const bf16_t*)(a.ws + WS_AS), (const bf16_t*)(a.ws + WS_BS), (float*)(a.ws + WS_PART), 2); }
#endif
    GSYNC();
    if (PHMASK & 8192) { PH_IDS
        if ((NPR % (2 * ngw)) == 0) for (int r = gw; r < NPR; r += 2 * ngw) rms_row2_f32(X + (size_t)r * D, X + (size_t)(r + ngw) * D, a.in[I_FN], lane);
        for (int r = ((NPR % (2 * ngw)) == 0 ? NPR : 0) + gw; r < MC; r += ngw) {
        float* xr = X + (size_t)r * D;
        if (r >= NPR) { const float* pp = (const float*)(a.ws + WS_PART) + (size_t)(r - NPR) * D;
#pragma unroll
            for (int j = 0; j < 8; ++j) { const int e = lane + 64 * j; f32x4 v = ((const f32x4*)pp)[e];
#pragma unroll
                for (int q = 1; q < NSL; ++q) v += ((const f32x4*)(pp + (size_t)q * TAILR * D))[e];
                ((f32x4*)xr)[e] = ((const f32x4*)xr)[e] + 0.5f * v; } }
        rms_row_f32(xr, a.in[I_FN], lane, r >= NPR ? DBG_SYS : 1.f);
    } }
}

extern "C" void kernel_launch(void* const* d_in, const int* in_sizes, int n_in, void* d_out, int out_size, void* d_ws, size_t ws_size, hipStream_t stream) {
    static int grid = 0;
    if (grid == 0) {
        if (n_in != N_IN || (size_t)out_size != O_END || ws_size < WS_END) { fprintf(stderr, "kernel_launch: unexpected shapes: n_in %d out %d ws %zu (need %zu)\n", n_in, out_size, ws_size, (size_t)WS_END); grid = -1; return; }
        int dev = 0, cus = 0, per_cu = 0;
        hipGetDevice(&dev);
        hipDeviceGetAttribute(&cus, hipDeviceAttributeMultiprocessorCount, dev);
        if (hipFuncSetAttribute((const void*)mk_fwd, hipFuncAttributeMaxDynamicSharedMemorySize, LDS_BYTES) != hipSuccess) { fprintf(stderr, "kernel_launch: hipFuncSetAttribute failed\n"); grid = -1; return; }
        if (hipOccupancyMaxActiveBlocksPerMultiprocessor(&per_cu, (const void*)mk_fwd, 512, LDS_BYTES) != hipSuccess || per_cu < 1) { fprintf(stderr, "kernel_launch: occupancy query says %d\n", per_cu); per_cu = 1; }
        (void)hipGetLastError();
        grid = cus * per_cu;
    }
    if (grid < 0) return;
    if (hipMemsetAsync(d_ws, 0, 4096, stream) != hipSuccess) { fprintf(stderr, "kernel_launch: memset failed\n"); return; }
    Args a{};
    for (int i = 0; i < N_IN; ++i) a.in[i] = (const float*)d_in[i];
    a.out = (float*)d_out; a.ws = (unsigned char*)d_ws;
    void* args[] = {&a};
    hipError_t e = hipLaunchCooperativeKernel((const void*)mk_fwd, dim3(grid), dim3(512), args, LDS_BYTES, stream);
    if (e != hipSuccess) fprintf(stderr, "cooperative launch failed: %s (grid %d)\n", hipGetErrorString(e), grid);
}
```
